# Optimizing an MI355X kernel written in HIP

```python
import jax, jax.numpy as jnp
from jax import lax
import numpy as np

D_MODEL = 1024
BATCH = 16
SEQ = 2048
DEPTH = 2
DEC_BATCH = 128
DEC_SEQ = 8
PAST_LEN = 16384
PAGE_SIZE = 128

D_MIX = D_MODEL
D_ATTN = D_MIX // 2
D_HG = D_MIX // 4
D_CONV = D_MIX - D_ATTN - D_HG
HEAD_DIM = 64
N_HEADS = D_ATTN // HEAD_DIM
N_KV_HEADS = 2
D_KV = N_KV_HEADS * HEAD_DIM
WINDOW = 128
ROPE_THETA = 10000.0
HG_DV = 64
HG_HEADS = D_HG // HG_DV
HG_DK = 64
D_FORGET = HG_HEADS * HG_DK
HG_CHUNK = 64
CONV_WIDTH = 3
D_IN = D_ATTN + 2 * D_KV + 2 * D_FORGET + 2 * D_HG + 3 * D_CONV
D_FF = 2816
FFN_RES_WEIGHT = 0.5
N_SUB = 3
RMS_EPS = 1e-6
NEG_BIG = -1e30

kernel_name = 'hymba_hgrn2_swa_conv_macaron_step'

F32 = jnp.float32


def rms_norm(x, g):
    xf = x.astype(F32)
    y = xf * lax.rsqrt(jnp.mean(xf * xf, axis=-1, keepdims=True) + RMS_EPS)
    return (y * g.astype(F32)).astype(x.dtype)


def rope(x, pos):
    half = x.shape[-1] // 2
    inv = jnp.power(ROPE_THETA, -jnp.arange(half, dtype=F32) / half)
    ang = pos.astype(F32)[:, None] * inv[None, :]
    cos = jnp.cos(ang)[None, :, None, :]
    sin = jnp.sin(ang)[None, :, None, :]
    xf = x.astype(F32)
    x1, x2 = xf[..., :half], xf[..., half:]
    return jnp.concatenate([x1 * cos - x2 * sin, x2 * cos + x1 * sin], axis=-1).astype(x.dtype)


def swiglu(h, w_in, w_out):
    g, u = jnp.split(h @ w_in, 2, axis=-1)
    return (jax.nn.silu(g) * u) @ w_out


def sink_attend(q, k, v, q_pos, k_pos, sinks):
    scale = HEAD_DIM ** -0.5
    s = jnp.einsum('bnqhgd,bnkhd->bnhgqk', q, k).astype(F32) * scale
    diff = q_pos[:, :, None] - k_pos[:, None, :]
    mask = (diff >= 0) & (diff < WINDOW) & (k_pos[:, None, :] >= 0)
    s = jnp.where(mask[None, :, None, None], s, NEG_BIG)
    sink = sinks.astype(F32).reshape(N_KV_HEADS, N_HEADS // N_KV_HEADS)[None, None, :, :, None, None]
    m = jnp.maximum(jnp.max(s, axis=-1, keepdims=True), sink)
    p = jnp.exp(s - m)
    p = p / (jnp.sum(p, axis=-1, keepdims=True) + jnp.exp(sink - m))
    return jnp.einsum('bnhgqk,bnkhd->bnqhgd', p.astype(v.dtype), v)


def window_attention(q, k, v, pos0, sinks, kv_prev):
    B, T = q.shape[0], q.shape[1]
    G = N_HEADS // N_KV_HEADS
    if kv_prev is None:
        nb = T // WINDOW
        qb = q.reshape(B, nb, WINDOW, N_KV_HEADS, G, HEAD_DIM)
        kb = k.reshape(B, nb, WINDOW, N_KV_HEADS, HEAD_DIM)
        vb = v.reshape(B, nb, WINDOW, N_KV_HEADS, HEAD_DIM)
        kk = jnp.concatenate([jnp.concatenate([jnp.zeros_like(kb[:, :1]), kb[:, :-1]], axis=1), kb], axis=2)
        vv = jnp.concatenate([jnp.concatenate([jnp.zeros_like(vb[:, :1]), vb[:, :-1]], axis=1), vb], axis=2)
        q_pos = pos0 + jnp.arange(T).reshape(nb, WINDOW)
        k_pos = pos0 + (jnp.arange(nb) * WINDOW)[:, None] + jnp.arange(-WINDOW, WINDOW)[None, :]
        o = sink_attend(qb, kk, vv, q_pos, k_pos, sinks)
        keep = min(WINDOW, T)
        new_k, new_v = k[:, T - keep:], v[:, T - keep:]
    else:
        k_prev, v_prev = kv_prev
        P = k_prev.shape[1]
        k_all = jnp.concatenate([k_prev.astype(k.dtype), k], axis=1)
        v_all = jnp.concatenate([v_prev.astype(v.dtype), v], axis=1)
        q_pos = (pos0 + jnp.arange(T))[None, :]
        k_pos = (pos0 - P + jnp.arange(P + T))[None, :]
        o = sink_attend(q.reshape(B, 1, T, N_KV_HEADS, G, HEAD_DIM), k_all[:, None], v_all[:, None],
                        q_pos, k_pos, sinks)
        new_k, new_v = k_all[:, T:], v_all[:, T:]
    return o.reshape(B, T, D_ATTN), new_k, new_v


def hgrn2_chunked(q, logf, v, S0):
    B, T = q.shape[0], q.shape[1]
    L = min(HG_CHUNK, T)
    nC = -(-T // L)
    pad = nC * L - T
    padw = ((0, 0), (0, pad), (0, 0), (0, 0))
    q = jnp.pad(q, padw)
    logf = jnp.pad(logf, padw)
    v = jnp.pad(v, padw)
    k = -jnp.expm1(logf)

    def to_chunks(a):
        return a.reshape(B, nC, L, HG_HEADS, a.shape[-1]).transpose(1, 0, 3, 2, 4)

    causal = jnp.tril(jnp.ones((L, L), dtype=bool))[None, None, :, :, None]

    def step(S, inp):
        qc, lfc, kc, vc = inp
        b = jnp.cumsum(lfc, axis=2)
        diff = b[:, :, :, None, :] - b[:, :, None, :, :]
        dec = jnp.exp(jnp.where(causal, diff, NEG_BIG))
        A = jnp.einsum('bhtk,bhsk,bhtsk->bhts', qc, kc, dec)
        o = jnp.einsum('bhts,bhsv->bhtv', A, vc) + jnp.einsum('bhtk,bhkv->bhtv', qc * jnp.exp(b), S)
        bL = b[:, :, -1:, :]
        S = jnp.exp(bL[:, :, 0, :])[..., None] * S + jnp.einsum('bhsk,bhsv->bhkv', kc * jnp.exp(bL - b), vc)
        return S, o

    S, o = lax.scan(step, S0, (to_chunks(q), to_chunks(logf), to_chunks(k), to_chunks(v)))
    o = o.transpose(1, 0, 3, 2, 4).reshape(B, nC * L, HG_HEADS, HG_DV)[:, :T]
    return o, S


def short_conv(u, prev, w):
    T = u.shape[1]
    full = jnp.concatenate([prev.astype(u.dtype), u], axis=1)
    y = full[:, 0:T] * w[0]
    for j in range(1, CONV_WIDTH):
        y = y + full[:, j:j + T] * w[j]
    return y, full[:, T:]


def mixer(h, pos0, kv_prev, S0, conv_prev, lb, w_in, w_out, sinks, gnorm, cw):
    B, T = h.shape[0], h.shape[1]
    sizes = [D_ATTN, D_KV, D_KV, D_FORGET, D_FORGET, D_HG, D_HG, D_CONV, D_CONV, D_CONV]
    z = h @ w_in
    qa, ka, va, qh, fh, ih, gh, bc, cc, hc = jnp.split(z, np.cumsum(sizes)[:-1].tolist(), axis=-1)
    pos = pos0 + jnp.arange(T)
    q = rope(qa.reshape(B, T, N_HEADS, HEAD_DIM), pos)
    k = rope(ka.reshape(B, T, N_KV_HEADS, HEAD_DIM), pos)
    v = va.reshape(B, T, N_KV_HEADS, HEAD_DIM)
    o_attn, new_k, new_v = window_attention(q, k, v, pos0, sinks, kv_prev)
    lbf = lb.reshape(HG_HEADS, HG_DK).astype(F32)
    f = lbf + (1.0 - lbf) * jax.nn.sigmoid(fh.reshape(B, T, HG_HEADS, HG_DK).astype(F32))
    logf = jnp.log(f)
    o_hg, S_new = hgrn2_chunked(qh.reshape(B, T, HG_HEADS, HG_DK).astype(F32), logf,
                                ih.reshape(B, T, HG_HEADS, HG_DV).astype(F32), S0.astype(F32))
    o_hg = rms_norm(o_hg, gnorm).reshape(B, T, D_HG).astype(h.dtype) * jax.nn.silu(gh)
    y_conv, conv_new = short_conv(cc * hc, conv_prev, cw)
    y_conv = bc * y_conv
    out = jnp.concatenate([o_attn, o_hg, y_conv], axis=-1) @ w_out
    return out, new_k, new_v, S_new, conv_new


def layer(x, c, pos0, kv_prev, S0, conv_prev, lb, p):
    a_w, a_b, g_pre, g_post, f_in, f_out, m_in, m_out, sinks, gnorm, cw = p
    B = x.shape[0]
    mod = (jax.nn.silu(c) @ a_w + a_b).reshape(B, N_SUB, 3, D_MODEL)[:, :, :, None, :]

    def modulate(y, i):
        return rms_norm(y, g_pre[i]) * (1.0 + mod[:, i, 1]) + mod[:, i, 0]

    def residual(y, out, i, w):
        return y + w * mod[:, i, 2] * rms_norm(out, g_post[i])

    x = residual(x, swiglu(modulate(x, 0), f_in[0], f_out[0]), 0, FFN_RES_WEIGHT)
    mix, new_k, new_v, S_new, conv_new = mixer(modulate(x, 1), pos0, kv_prev, S0, conv_prev, lb,
                                                m_in, m_out, sinks, gnorm, cw)
    x = residual(x, mix, 1, 1.0)
    x = residual(x, swiglu(modulate(x, 2), f_in[1], f_out[1]), 2, FFN_RES_WEIGHT)
    return x, new_k, new_v, S_new, conv_new


def setup_inputs(seed: int = 0) -> dict:
    key = jax.random.key(seed)
    ks = jax.random.split(key, 24)

    def nrm(k, shape, s):
        return jax.random.normal(k, shape, F32) * s

    win_buf = min(WINDOW, PAST_LEN)
    return {
        'x_prompt': nrm(ks[0], (BATCH, SEQ, D_MODEL), 1.0),
        'x_sample': nrm(ks[1], (DEC_BATCH, DEC_SEQ, D_MODEL), 1.0),
        'cache_k_win': nrm(ks[2], (DEPTH, DEC_BATCH, win_buf, N_KV_HEADS, HEAD_DIM), 1.0),
        'cache_v_win': nrm(ks[3], (DEPTH, DEC_BATCH, win_buf, N_KV_HEADS, HEAD_DIM), 1.0),
        'state_hgrn': nrm(ks[4], (DEPTH, DEC_BATCH, HG_HEADS, HG_DK, HG_DV), 0.5),
        'state_conv': nrm(ks[5], (DEPTH, DEC_BATCH, CONV_WIDTH - 1, D_CONV), 1.0),
        'c_prompt': nrm(ks[6], (BATCH, D_MODEL), 1.0),
        'c_sample': nrm(ks[7], (DEC_BATCH, D_MODEL), 1.0),
        'ada_w': nrm(ks[8], (DEPTH, D_MODEL, N_SUB * 3 * D_MODEL), 0.5 * D_MODEL ** -0.5),
        'ada_b': nrm(ks[9], (DEPTH, N_SUB * 3 * D_MODEL), 0.01),
        'norm_pre': 1.0 + nrm(ks[10], (DEPTH, N_SUB, D_MODEL), 0.05),
        'norm_post': 1.0 + nrm(ks[11], (DEPTH, N_SUB, D_MODEL), 0.05),
        'ffn_w_in': nrm(ks[12], (DEPTH, 2, D_MODEL, 2 * D_FF), D_MODEL ** -0.5),
        'ffn_w_out': nrm(ks[13], (DEPTH, 2, D_FF, D_MODEL), D_FF ** -0.5),
        'mix_w_in': nrm(ks[14], (DEPTH, D_MODEL, D_IN), D_MODEL ** -0.5),
        'mix_w_out': nrm(ks[15], (DEPTH, D_MIX, D_MODEL), D_MIX ** -0.5),
        'attn_sinks': nrm(ks[16], (DEPTH, N_HEADS), 0.5),
        'hgrn_lower_bounds': nrm(ks[17], (DEPTH, D_FORGET), 0.5),
        'hgrn_gnorm': 1.0 + nrm(ks[18], (DEPTH, HG_DV), 0.05),
        'conv_w': nrm(ks[19], (DEPTH, CONV_WIDTH, D_CONV), CONV_WIDTH ** -0.5),
    }


def reference(x_prompt, x_sample, cache_k_win, cache_v_win, state_hgrn, state_conv, c_prompt, c_sample,
              ada_w, ada_b, norm_pre, norm_post, ffn_w_in, ffn_w_out, mix_w_in, mix_w_out,
              attn_sinks, hgrn_lower_bounds, hgrn_gnorm, conv_w):
    sm = jax.nn.softmax(hgrn_lower_bounds.astype(F32), axis=0)
    lbs = jnp.cumsum(sm, axis=0) - sm[0:1]

    yp, ys = x_prompt, x_sample
    kp_l, vp_l, sp_l, cp_l = [], [], [], []
    ks_l, vs_l, ss_l, cs_l = [], [], [], []
    for l in range(DEPTH):
        p = (ada_w[l], ada_b[l], norm_pre[l], norm_post[l], ffn_w_in[l], ffn_w_out[l],
             mix_w_in[l], mix_w_out[l], attn_sinks[l], hgrn_gnorm[l], conv_w[l])
        S0p = jnp.zeros((yp.shape[0], HG_HEADS, HG_DK, HG_DV), F32)
        cv0p = jnp.zeros((yp.shape[0], CONV_WIDTH - 1, D_CONV), yp.dtype)
        yp, k1, v1, s1, c1 = layer(yp, c_prompt, 0, None, S0p, cv0p, lbs[l], p)
        ys, k2, v2, s2, c2 = layer(ys, c_sample, PAST_LEN, (cache_k_win[l], cache_v_win[l]),
                                   state_hgrn[l], state_conv[l], lbs[l], p)
        kp_l.append(k1); vp_l.append(v1); sp_l.append(s1.astype(state_hgrn.dtype)); cp_l.append(c1)
        ks_l.append(k2); vs_l.append(v2); ss_l.append(s2.astype(state_hgrn.dtype)); cs_l.append(c2)

    new_k_win_prompt = jnp.stack(kp_l)
    new_v_win_prompt = jnp.stack(vp_l)
    new_state_hgrn_prompt = jnp.stack(sp_l)
    new_state_conv_prompt = jnp.stack(cp_l)
    new_k_win_sample = jnp.stack(ks_l)
    new_v_win_sample = jnp.stack(vs_l)
    new_state_hgrn_sample = jnp.stack(ss_l)
    new_state_conv_sample = jnp.stack(cs_l)
    return (yp, ys, new_k_win_prompt, new_v_win_prompt, new_state_hgrn_prompt, new_state_conv_prompt,
            new_k_win_sample, new_v_win_sample, new_state_hgrn_sample, new_state_conv_sample)
```

```cpp
#include <hip/hip_runtime.h>
#include <hip/hip_cooperative_groups.h>
#include <cstdio>
#include <cstdint>
namespace cg = cooperative_groups;
namespace pg8 {
#define PG8_LAS __attribute__((address_space(3)))
typedef unsigned short bf16_t;
typedef short bf16x8 __attribute__((ext_vector_type(8)));
typedef float f32x4 __attribute__((ext_vector_type(4)));
typedef unsigned u32x4 __attribute__((ext_vector_type(4)));
constexpr int BM = 256, BK = 64, HALF = 128, HTB = HALF * BK * 2  , STAGE_BYTES = 8 * HTB, NXCD = 8, WGM = 8;

__host__ __device__ __forceinline__ int lds_byte(int r, int c) { const int st = (r >> 4) * 2 + (c >> 5), rr = r & 15, cc = c & 31, ob = rr * 64 + cc * 2; return st * 1024 + (ob ^ (((ob >> 9) & 1) << 5)); }
__host__ __device__ __forceinline__ void stage_rc(int b, int& R, int& C) { const int st = b / 1024, sb = b % 1024, swz = sb ^ (((sb >> 9) & 1) << 5); R = (st >> 1) * 16 + swz / 64; C = (st & 1) * 32 + (swz % 64) / 2; }
__host__ __device__ __forceinline__ int perm32(int rho) { const int n = rho >> 4, i = rho & 15; return 8 * (i >> 2) + 4 * n + (i & 3); }

struct Unit { int pm, pn; };
struct Gemm { const bf16_t* A; const bf16_t* Bt; int M, N, K; };

struct StaticOrder {
    int nM, nN, nwg, G, c;
    __host__ __device__ void init(int M, int N, int G_, int c_) { nM = M / BM; nN = N / BM; nwg = nM * nN; G = G_; c = c_; }
    __host__ __device__ bool next(int i, Unit& u) const {
        const long L = (long)i * G + c; if (L >= nwg) return false;
        int wgid = (int)L; { const int q = nwg / NXCD, r = nwg % NXCD, xcd = wgid % NXCD, off = wgid / NXCD; wgid = (xcd < r ? xcd * (q + 1) : r * (q + 1) + (xcd - r) * q) + off; }
        const int nig = WGM * nN, gid = wgid / nig, fm = gid * WGM, gsz = (nM - fm) < WGM ? (nM - fm) : WGM;
        u.pm = fm + ((wgid % nig) % gsz); u.pn = (wgid % nig) / gsz; return true;
    }
    __device__ __forceinline__ void a_ready(const Unit&) const {}
    __device__ __forceinline__ void done(const Unit&) const {}
};

__device__ __forceinline__ unsigned cvt_pk_bf16(float lo, float hi) { unsigned r; asm volatile("v_cvt_pk_bf16_f32 %0, %1, %2" : "=v"(r) : "v"(lo), "v"(hi)); return r; }
typedef float f32x2 __attribute__((ext_vector_type(2)));
struct EpiBf16 {
    static constexpr bool PERM = true, AFTER_DRAIN = false;
    bf16_t* O; int ldc;
    __device__ __forceinline__ void operator()(const f32x4 (&acc)[2][2][4][2], const Unit& u, int wr, int wc, int fr, int fq) const {
        const int row0 = u.pm * BM + wr * 64 + fr; const int col0 = u.pn * BM + wc * 32 + 8 * fq;
#pragma unroll
        for (int ai = 0; ai < 2; ++ai)
#pragma unroll
            for (int m = 0; m < 4; ++m) { bf16_t* rowp = O + (size_t)(row0 + ai * HALF + m * 16) * ldc + col0;
#pragma unroll
                for (int bj = 0; bj < 2; ++bj) { const f32x4 v0 = acc[ai][bj][m][0], v1 = acc[ai][bj][m][1];
                    u32x4 w; w.x = cvt_pk_bf16(v0[0], v0[1]); w.y = cvt_pk_bf16(v0[2], v0[3]); w.z = cvt_pk_bf16(v1[0], v1[1]); w.w = cvt_pk_bf16(v1[2], v1[3]);
                    *(u32x4*)(rowp + bj * HALF) = w; } }
    }
};
struct EpiSwiGLU {
    static constexpr bool PERM = true, AFTER_DRAIN = false;
    bf16_t* O; int ldc;
    __device__ __forceinline__ void operator()(const f32x4 (&acc)[2][2][4][2], const Unit& u, int wr, int wc, int fr, int fq) const {
        const int row0 = u.pm * BM + wr * 64 + fr; const int col0 = u.pn * HALF + wc * 32 + 8 * fq;
#pragma unroll
        for (int ai = 0; ai < 2; ++ai)
#pragma unroll
            for (int m = 0; m < 4; ++m) { bf16_t* rowp = O + (size_t)(row0 + ai * HALF + m * 16) * ldc + col0;
                float r[8];
#pragma unroll
                for (int n = 0; n < 2; ++n)
#pragma unroll
                    for (int e = 0; e < 4; ++e) { const float g = acc[ai][0][m][n][e], up = acc[ai][1][m][n][e];
                        r[n * 4 + e] = g * __builtin_amdgcn_rcpf(1.0f + __expf(-g)) * up; }
                u32x4 w; w.x = cvt_pk_bf16(r[0], r[1]); w.y = cvt_pk_bf16(r[2], r[3]); w.z = cvt_pk_bf16(r[4], r[5]); w.w = cvt_pk_bf16(r[6], r[7]);
                *(u32x4*)rowp = w; }
    }
};
struct EpiModF32 {
    static constexpr bool PERM = false, AFTER_DRAIN = false;
    float* O; const float* bias; int nrows; int ncols_l;
    __device__ __forceinline__ void operator()(const f32x4 (&acc)[2][2][4][2], const Unit& u, int wr, int wc, int fr, int fq) const {
        const int colt = u.pn * BM + wc * 32 + 4 * fq;
#pragma unroll
        for (int ai = 0; ai < 2; ++ai)
#pragma unroll
            for (int m = 0; m < 4; ++m) { const int r = u.pm * BM + ai * HALF + wr * 64 + m * 16 + fr;
                if (r < nrows) {
#pragma unroll
                    for (int bj = 0; bj < 2; ++bj)
#pragma unroll
                        for (int n = 0; n < 2; ++n) { const int c = colt + bj * HALF + n * 16; const int l = c / ncols_l, cc = c - l * ncols_l;
                            const f32x4 bv = *(const f32x4*)(bias + c);
                            *(f32x4*)(O + ((size_t)l * nrows + r) * ncols_l + cc) = acc[ai][bj][m][n] + bv; } } }
    }
};
template <class Epi, class Sched, bool ALIGN_EPI = false, bool SP2 = false>
__device__ __forceinline__ void gemm_phase(PG8_LAS unsigned char* lds, const Gemm g, const Sched& S, const Epi& E) {
    const int tid = threadIdx.x, wid = __builtin_amdgcn_readfirstlane(tid >> 6), lane = tid & 63, wr = wid >> 2, wc = wid & 3, fr = lane & 15, fq = lane >> 4;
    const int K = g.K, nt = K / BK;
    unsigned voffA[2], voffB[2];
#pragma unroll
    for (int i = 0; i < 2; ++i) { int R, C; stage_rc(tid * 16 + i * 8192, R, C); const int Rb = Epi::PERM ? ((R & ~31) + perm32(R & 31)) : R;
        voffA[i] = (unsigned)(R * K + C) * 2u; voffB[i] = (unsigned)(Rb * K + C) * 2u; }
    const size_t kstep = (size_t)(BK * 2);
    const size_t hstep = (size_t)HALF * K * 2;
    const size_t tstep = 2 * hstep;
    const unsigned ldsw = (unsigned)wid * 1024u;
    const int aoff = lds_byte(wr * 64 + fr, fq * 8), boff = lds_byte(wc * 32 + fr, fq * 8);
#define PG8_SA(b, h) (((b) * 2 + (h)) * HTB)
#define PG8_SB(b, h) ((4 + (b) * 2 + (h)) * HTB)
#define PG8_STAGE(bufoff, gbase, voff) do { _Pragma("unroll") for (int _i = 0; _i < 2; ++_i) \
        __builtin_amdgcn_global_load_lds((const unsigned*)((const char*)(gbase) + (voff)[_i]), (PG8_LAS unsigned*)(lds + (bufoff) + ldsw + _i * 8192), 16, 0, 0); } while (0)
#define PG8_LDA(dst, b, h) do { _Pragma("unroll") for (int m = 0; m < 4; ++m) _Pragma("unroll") for (int k = 0; k < 2; ++k) dst[m][k] = *(const PG8_LAS bf16x8*)(lds + PG8_SA(b, h) + aoff + m * 2048 + k * 1024); } while (0)
#define PG8_LDB(dst, b, h) do { _Pragma("unroll") for (int n = 0; n < 2; ++n) _Pragma("unroll") for (int k = 0; k < 2; ++k) dst[n][k] = *(const PG8_LAS bf16x8*)(lds + PG8_SB(b, h) + boff + n * 2048 + k * 1024); } while (0)
#define PG8_MMA(ai, bj, At, Bt) do { __builtin_amdgcn_s_setprio(1); _Pragma("unroll") for (int m = 0; m < 4; ++m) _Pragma("unroll") for (int n = 0; n < 2; ++n) _Pragma("unroll") for (int k = 0; k < 2; ++k) \
        acc[ai][bj][m][n] = __builtin_amdgcn_mfma_f32_16x16x32_bf16(Bt[n][k], At[m][k], acc[ai][bj][m][n], 0, 0, 0); __builtin_amdgcn_s_setprio(0); } while (0)
#define PG8_WAIT_V(n) asm volatile("s_waitcnt vmcnt(" #n ")" ::: "memory")
#define PG8_WAIT_L(n) asm volatile("s_waitcnt lgkmcnt(" #n ")" ::: "memory")
#define PG8_BAR __builtin_amdgcn_s_barrier()
#define PG8_SCHED __builtin_amdgcn_sched_barrier(0)
    Unit cur, nxt; int ui = 0;
    if (!S.next(0, cur)) return;
    f32x4 acc[2][2][4][2];
#pragma unroll
    for (int a = 0; a < 2; ++a)
#pragma unroll
        for (int b = 0; b < 2; ++b)
#pragma unroll
            for (int m = 0; m < 4; ++m)
#pragma unroll
                for (int n = 0; n < 2; ++n) acc[a][b][m][n] = (f32x4){0.f, 0.f, 0.f, 0.f};
    bf16x8 At[4][2], B0[2][2], B1[2][2];
    const char* cA = (const char*)g.A + (size_t)cur.pm * tstep; const char* cB = (const char*)g.Bt + (size_t)cur.pn * tstep;
    S.a_ready(cur);
    if constexpr (SP2) {
        PG8_STAGE(PG8_SB(0, 0), cB, voffB); PG8_STAGE(PG8_SB(0, 1), cB + hstep, voffB); PG8_STAGE(PG8_SA(0, 0), cA, voffA); PG8_STAGE(PG8_SA(0, 1), cA + hstep, voffA);
        if (wr == 1) PG8_BAR;
        PG8_WAIT_V(2); PG8_BAR;
        PG8_STAGE(PG8_SB(1, 0), cB + kstep, voffB); PG8_STAGE(PG8_SA(1, 0), cA + kstep, voffA); PG8_STAGE(PG8_SB(1, 1), cB + hstep + kstep, voffB);
        PG8_WAIT_V(6); PG8_BAR;
    } else {
        PG8_STAGE(PG8_SB(0, 0), cB, voffB); PG8_STAGE(PG8_SA(0, 0), cA, voffA); PG8_STAGE(PG8_SB(0, 1), cB + hstep, voffB); PG8_STAGE(PG8_SA(0, 1), cA + hstep, voffA);
        if (wr == 1) PG8_BAR;
        PG8_WAIT_V(4); PG8_BAR;
        PG8_STAGE(PG8_SB(1, 0), cB + kstep, voffB); PG8_STAGE(PG8_SA(1, 0), cA + kstep, voffA); PG8_STAGE(PG8_SB(1, 1), cB + hstep + kstep, voffB);
        PG8_WAIT_V(6); PG8_BAR;
    }
    for (;;) {
        const bool has_next = S.next(ui + 1, nxt);
        const char* nA = has_next ? (const char*)g.A + (size_t)nxt.pm * tstep : cA; const char* nB = has_next ? (const char*)g.Bt + (size_t)nxt.pn * tstep : cB;
        for (int t = 0; t < nt; t += 2) {
            const bool last = (t == nt - 2);
            const char* a1 = cA + (size_t)(t + 1) * kstep;
            const char* a2 = last ? nA : cA + (size_t)(t + 2) * kstep; const char* b2 = last ? nB : cB + (size_t)(t + 2) * kstep;
            const char* a3 = a2 + kstep; const char* b3 = b2 + kstep;
            if (last && has_next) S.a_ready(nxt);
            if constexpr (SP2) {
            PG8_LDB(B0, 0, 0); PG8_LDB(B1, 0, 1); PG8_SCHED; PG8_LDA(At, 0, 0); PG8_STAGE(PG8_SA(1, 1), a1 + hstep, voffA);
            PG8_WAIT_V(8); PG8_WAIT_L(0); PG8_BAR; PG8_MMA(0, 0, At, B0); PG8_MMA(0, 1, At, B1); PG8_BAR; PG8_SCHED;
            PG8_LDA(At, 0, 1); PG8_STAGE(PG8_SB(0, 0), b2, voffB); PG8_STAGE(PG8_SB(0, 1), b2 + hstep, voffB); PG8_STAGE(PG8_SA(0, 0), a2, voffA);
            PG8_WAIT_V(8); PG8_WAIT_L(0); PG8_BAR; PG8_MMA(1, 0, At, B0); PG8_MMA(1, 1, At, B1); PG8_BAR; PG8_SCHED;
            PG8_LDB(B0, 1, 0); PG8_LDB(B1, 1, 1); PG8_SCHED; PG8_LDA(At, 1, 0); PG8_STAGE(PG8_SA(0, 1), a2 + hstep, voffA);
            PG8_WAIT_V(8); PG8_WAIT_L(0); PG8_BAR; PG8_MMA(0, 0, At, B0); PG8_MMA(0, 1, At, B1); PG8_BAR; PG8_SCHED;
            PG8_LDA(At, 1, 1); PG8_STAGE(PG8_SB(1, 0), b3, voffB); PG8_STAGE(PG8_SB(1, 1), b3 + hstep, voffB); PG8_STAGE(PG8_SA(1, 0), a3, voffA);
            PG8_WAIT_V(8); PG8_WAIT_L(0); PG8_BAR; PG8_MMA(1, 0, At, B0); PG8_MMA(1, 1, At, B1); PG8_BAR; PG8_SCHED;
            } else {
            PG8_LDB(B0, 0, 0); PG8_SCHED; PG8_LDA(At, 0, 0); PG8_STAGE(PG8_SA(1, 1), a1 + hstep, voffA);
            PG8_WAIT_L(8); PG8_BAR; PG8_WAIT_L(0); PG8_MMA(0, 0, At, B0); PG8_BAR; PG8_SCHED;
            PG8_LDB(B1, 0, 1); PG8_STAGE(PG8_SB(0, 0), b2, voffB);
            PG8_BAR; PG8_WAIT_L(0); PG8_MMA(0, 1, At, B1); PG8_BAR;
            PG8_LDA(At, 0, 1); PG8_STAGE(PG8_SA(0, 0), a2, voffA);
            PG8_BAR; PG8_WAIT_L(0); PG8_MMA(1, 0, At, B0); PG8_BAR; PG8_SCHED;
            PG8_STAGE(PG8_SB(0, 1), b2 + hstep, voffB);
            PG8_WAIT_V(6); PG8_BAR; PG8_MMA(1, 1, At, B1); PG8_BAR;
            PG8_LDB(B0, 1, 0); PG8_SCHED; PG8_LDA(At, 1, 0); PG8_STAGE(PG8_SA(0, 1), a2 + hstep, voffA);
            PG8_WAIT_L(8); PG8_BAR; PG8_WAIT_L(0); PG8_MMA(0, 0, At, B0); PG8_BAR; PG8_SCHED;
            PG8_LDB(B1, 1, 1); PG8_STAGE(PG8_SB(1, 0), b3, voffB);
            PG8_BAR; PG8_WAIT_L(0); PG8_MMA(0, 1, At, B1); PG8_BAR;
            PG8_LDA(At, 1, 1); PG8_STAGE(PG8_SA(1, 0), a3, voffA);
            PG8_BAR; PG8_WAIT_L(0); PG8_MMA(1, 0, At, B0); PG8_BAR; PG8_SCHED;
            PG8_STAGE(PG8_SB(1, 1), b3 + hstep, voffB);
            PG8_WAIT_V(6); PG8_BAR; PG8_MMA(1, 1, At, B1); PG8_BAR;
            }
        }
        if constexpr (ALIGN_EPI) { if (wr == 0) PG8_BAR; }
        if constexpr (!Epi::AFTER_DRAIN) { E(acc, cur, wr, wc, fr, fq); S.done(cur); }
        if (!has_next) break;
#pragma unroll
        for (int a = 0; a < 2; ++a)
#pragma unroll
            for (int b = 0; b < 2; ++b)
#pragma unroll
                for (int m = 0; m < 4; ++m)
#pragma unroll
                    for (int n = 0; n < 2; ++n) acc[a][b][m][n] = (f32x4){0.f, 0.f, 0.f, 0.f};
        cur = nxt; cA = nA; cB = nB; ++ui;
        if constexpr (ALIGN_EPI) { if (wr == 1) PG8_BAR; }
    }
    PG8_WAIT_V(0);
    if constexpr (!ALIGN_EPI) { if (wr == 0) PG8_BAR; }
    PG8_BAR;
    if constexpr (Epi::AFTER_DRAIN) { E.fused(acc, cur, wr, wc, fr, fq, lds, wid, lane); S.done(cur); }
#undef PG8_SA
#undef PG8_SB
#undef PG8_STAGE
#undef PG8_LDA
#undef PG8_LDB
#undef PG8_MMA
#undef PG8_WAIT_V
#undef PG8_WAIT_L
#undef PG8_BAR
#undef PG8_SCHED
}
}
typedef unsigned short bf16_t;
typedef short bf16x8 __attribute__((ext_vector_type(8)));
typedef short s16x4 __attribute__((ext_vector_type(4)));
typedef float f32x4 __attribute__((ext_vector_type(4)));
typedef float f32x16 __attribute__((ext_vector_type(16)));
typedef unsigned u32x4 __attribute__((ext_vector_type(4)));
typedef unsigned u32x2 __attribute__((ext_vector_type(2)));
#define LAS __attribute__((address_space(3)))
#define DI __device__ __forceinline__

constexpr int DM = 1024, NB = 16, SEQ = 2048, NL = 2, DB = 128, DS = 8, PAST = 16384;
constexpr int MP = NB * SEQ, MS = DB * DS, MT = MP + MS;
constexpr int DIN = 2560, DFF = 2816, NBT = NB + DB, NMOD = 9 * DM;
constexpr int QA = 0, KA = 512, VA = 640, QH = 768, FH = 1024, IH = 1280, GH = 1536, BC = 1792, CC = 2048, HC = 2304;
constexpr float EPS = 1e-6f;
constexpr int NTHREADS = 512;
constexpr int LDS_BYTES = 147456;

constexpr size_t MiB = 1u << 20;
constexpr size_t WS_MOD = 0;
constexpr size_t WS_ROPE = 11 * MiB;
constexpr size_t WS_AMOD = 12 * MiB;
constexpr size_t WS_WADA = 13 * MiB;
constexpr size_t WS_WIN = 49 * MiB;
constexpr size_t WS_WOUT = 93 * MiB;
constexpr size_t WS_WMIN = 115 * MiB;
constexpr size_t WS_WMOUT = 125 * MiB;
constexpr size_t WS_H = 129 * MiB;
constexpr size_t WS_BIG = 195 * MiB;
constexpr size_t WS_OUT = 377 * MiB;
constexpr size_t WS_END = 443 * MiB;
constexpr size_t WS_HU = WS_OUT;
constexpr size_t WS_HD = WS_OUT + 32 * MiB;

constexpr size_t O_X = 0;
constexpr size_t O_KP = (size_t)MT * DM;
constexpr size_t O_VP = O_KP + 524288;
constexpr size_t O_SP = O_VP + 524288;
constexpr size_t O_CP = O_SP + 524288;
constexpr size_t O_KS = O_CP + 16384;
constexpr size_t O_VS = O_KS + 4194304;
constexpr size_t O_SS = O_VS + 4194304;
constexpr size_t O_CS = O_SS + 4194304;
constexpr size_t O_END = O_CS + 131072;

struct Args { const float* in[20]; float* out; unsigned char* ws; };

DI unsigned f2bf(float f) { unsigned u = __float_as_uint(f); return (u + 0x7fffu + ((u >> 16) & 1u)) >> 16; }
DI unsigned pk2(float lo, float hi) { return f2bf(lo) | (f2bf(hi) << 16); }
DI float bflo(unsigned w) { return __uint_as_float(w << 16); }
DI float bfhi(unsigned w) { return __uint_as_float(w & 0xffff0000u); }
DI float bf2f(bf16_t b) { return __uint_as_float((unsigned)b << 16); }
DI void unpack8(const u32x4 w, float (&x)[8]) { x[0] = bflo(w.x); x[1] = bfhi(w.x); x[2] = bflo(w.y); x[3] = bfhi(w.y); x[4] = bflo(w.z); x[5] = bfhi(w.z); x[6] = bflo(w.w); x[7] = bfhi(w.w); }
DI u32x4 pack8(const float (&x)[8]) { u32x4 w; w.x = pk2(x[0], x[1]); w.y = pk2(x[2], x[3]); w.z = pk2(x[4], x[5]); w.w = pk2(x[6], x[7]); return w; }
DI float sigmoidf_(float x) { return __builtin_amdgcn_rcpf(1.0f + __expf(-x)); }
DI float wave_sum(float v) {
#pragma unroll
    for (int o = 1; o < 64; o <<= 1) v += __shfl_xor(v, o);
    return v;
}
DI int crow(int r, int hi) { return (r & 3) + 8 * (r >> 2) + 4 * hi; }
#define MFMA32(a, b, c) __builtin_amdgcn_mfma_f32_32x32x16_bf16((a), (b), (c), 0, 0, 0)
#define MFMA16(a, b, c) __builtin_amdgcn_mfma_f32_16x16x32_bf16((a), (b), (c), 0, 0, 0)

DI int mod_row(int r) { return r < MP ? (r >> 11) : NB + ((r - MP) >> 3); }

DI void transpose_item(const float* W, int K, int N, bf16_t* WT, int k0, int n0, int drow0, float* scr, int lane) {
#pragma unroll 8
    for (int i = 0; i < 32; ++i) { const int kk = 2 * i + (lane >> 5); scr[kk * 33 + (lane & 31)] = W[(size_t)(k0 + kk) * N + n0 + (lane & 31)]; }
    __builtin_amdgcn_wave_barrier(); asm volatile("s_waitcnt lgkmcnt(0)" ::: "memory");
    const int c = lane & 7;
#pragma unroll
    for (int j = 0; j < 4; ++j) { const int n = (lane >> 3) + 8 * j; const float* s = scr + (8 * c) * 33 + n;
        u32x4 o; o.x = pk2(s[0 * 33], s[1 * 33]); o.y = pk2(s[2 * 33], s[3 * 33]); o.z = pk2(s[4 * 33], s[5 * 33]); o.w = pk2(s[6 * 33], s[7 * 33]);
        *(u32x4*)(WT + (size_t)(drow0 + n) * K + k0 + 8 * c) = o; }
    __builtin_amdgcn_wave_barrier(); asm volatile("s_waitcnt lgkmcnt(0)" ::: "memory");
}

DI void sincos_acc(float ang, float& c, float& s) {
    const double TWO_PI = 6.283185307179586476925286766559, INV_2PI = 0.15915494309189533576888376337251;
    double a = (double)ang; double n = rint(a * INV_2PI); double r = fma(-n, TWO_PI, a);
    double r2 = r * r;
    double sn = -1.0 / 51090942171709440000.0;
    sn = fma(sn, r2, 1.0 / 121645100408832000.0); sn = fma(sn, r2, -1.0 / 355687428096000.0); sn = fma(sn, r2, 1.0 / 1307674368000.0); sn = fma(sn, r2, -1.0 / 6227020800.0);
    sn = fma(sn, r2, 1.0 / 39916800.0); sn = fma(sn, r2, -1.0 / 362880.0); sn = fma(sn, r2, 1.0 / 5040.0); sn = fma(sn, r2, -1.0 / 120.0); sn = fma(sn, r2, 1.0 / 6.0);
    sn = fma(sn, r2, -1.0); sn = -sn * r;
    double cs = 1.0 / 2432902008176640000.0;
    cs = fma(cs, r2, -1.0 / 6402373705728000.0); cs = fma(cs, r2, 1.0 / 20922789888000.0); cs = fma(cs, r2, -1.0 / 87178291200.0); cs = fma(cs, r2, 1.0 / 479001600.0);
    cs = fma(cs, r2, -1.0 / 3628800.0); cs = fma(cs, r2, 1.0 / 40320.0); cs = fma(cs, r2, -1.0 / 720.0); cs = fma(cs, r2, 1.0 / 24.0); cs = fma(cs, r2, -0.5); cs = fma(cs, r2, 1.0);
    c = (float)cs; s = (float)sn;
}

DI void p0_prologue(const Args& A, unsigned char* lds, int tid, int lane, int wave) {
    unsigned char* ws = A.ws;
    float* scr = (float*)(lds + wave * 16384);
    const int gw = blockIdx.x * 8 + wave, NGW = gridDim.x * 8;
    constexpr int I_ADA = 2 * 16 * 288, I_IN = 4 * 16 * 176, I_OUT = 4 * 44 * 32, I_MIN = 2 * 16 * 80, I_MOUT = 2 * 16 * 32;
    constexpr int NITEMS = I_ADA + I_IN + I_OUT + I_MIN + I_MOUT;
    for (int it0 = gw; it0 < NITEMS; it0 += NGW) {
        int it = it0; const float* W; bf16_t* WT; int K, N, r; bool swz = false;
        if (it < I_ADA) { const int l = it / 4608; r = it % 4608; K = 1024; N = 9216; W = A.in[8] + (size_t)l * K * N; WT = (bf16_t*)(ws + WS_WADA) + (size_t)l * N * K; }
        else if ((it -= I_ADA) < I_IN) { const int m = it / 2816; r = it % 2816; K = 1024; N = 5632; W = A.in[12] + (size_t)m * K * N; WT = (bf16_t*)(ws + WS_WIN) + (size_t)m * N * K; swz = true; }
        else if ((it -= I_IN) < I_OUT) { const int m = it / 1408; r = it % 1408; K = 2816; N = 1024; W = A.in[13] + (size_t)m * K * N; WT = (bf16_t*)(ws + WS_WOUT) + (size_t)m * N * K; }
        else if ((it -= I_OUT) < I_MIN) { const int l = it / 1280; r = it % 1280; K = 1024; N = 2560; W = A.in[14] + (size_t)l * K * N; WT = (bf16_t*)(ws + WS_WMIN) + (size_t)l * N * K; }
        else { it -= I_MIN; const int l = it / 512; r = it % 512; K = 1024; N = 1024; W = A.in[15] + (size_t)l * K * N; WT = (bf16_t*)(ws + WS_WMOUT) + (size_t)l * N * K; }
        const int nblk = N / 32, kb = r / nblk, nb = r % nblk, k0 = 64 * kb, n0 = 32 * nb;
        int drow0 = n0;
        if (swz) { const int j = n0 < DFF ? n0 : n0 - DFF; drow0 = (j >> 7) * 256 + (j & 127) + (n0 < DFF ? 0 : 128); }
        transpose_item(W, K, N, WT, k0, n0, drow0, scr, lane);
    }
    const int gt = blockIdx.x * NTHREADS + tid, NGT = gridDim.x * NTHREADS;
    bf16_t* amod = (bf16_t*)(ws + WS_AMOD);
    for (int e = gt; e < 256 * 1024; e += NGT) { const int r = e >> 10, d = e & 1023; float v = 0.f;
        if (r < NB) v = A.in[6][r * DM + d]; else if (r < NBT) v = A.in[7][(r - NB) * DM + d];
        amod[e] = (bf16_t)f2bf(v * sigmoidf_(v)); }
    float* rope = (float*)(ws + WS_ROPE);
    for (int e = gt; e < 2056 * 32; e += NGT) { const int idx = e >> 5, j = e & 31; const int pos = idx < 2048 ? idx : PAST + idx - 2048;
        const float inv = powf(10000.0f, -(float)j / 32.0f); const float ang = (float)pos * inv; float c, s; sincos_acc(ang, c, s);
        rope[2 * e] = c; rope[2 * e + 1] = s; }
}

DI void row_pass(const Args& A, bool has_post, int lp, int ip, float resw, bool has_pre, int ln, int inn, bool from_input, int lane, int wave) {
    unsigned char* ws = A.ws;
    const float* mod = (const float*)(ws + WS_MOD);
    const bf16_t* OUT = (const bf16_t*)(ws + WS_OUT); bf16_t* H = (bf16_t*)(ws + WS_H);
    float* X = A.out + O_X;
    const int gw = blockIdx.x * 8 + wave, NGW = gridDim.x * 8;
    const float* gpost = A.in[11] + ((size_t)lp * 3 + ip) * DM; const float* gpre = A.in[10] + ((size_t)ln * 3 + inn) * DM;
    for (int r = gw; r < MT; r += NGW) {
        const int br = mod_row(r);
        const float* xs = from_input ? (r < MP ? A.in[0] + (size_t)r * DM : A.in[1] + (size_t)(r - MP) * DM) : X + (size_t)r * DM;
        f32x4 x[4];
#pragma unroll
        for (int j = 0; j < 4; ++j) x[j] = *(const f32x4*)(xs + 256 * j + 4 * lane);
        if (has_post) {
            const float* gate = mod + ((size_t)lp * NBT + br) * NMOD + (ip * 3 + 2) * DM;
            f32x4 o[4]; float ss = 0.f;
#pragma unroll
            for (int j = 0; j < 4; ++j) { const u32x2 w = *(const u32x2*)(OUT + (size_t)r * DM + 256 * j + 4 * lane);
                o[j] = (f32x4){bflo(w.x), bfhi(w.x), bflo(w.y), bfhi(w.y)}; ss += (o[j].x * o[j].x + o[j].y * o[j].y) + (o[j].z * o[j].z + o[j].w * o[j].w); }
            const float rstd = rsqrtf(wave_sum(ss) * (1.0f / DM) + EPS) * resw;
#pragma unroll
            for (int j = 0; j < 4; ++j) { const f32x4 g = *(const f32x4*)(gate + 256 * j + 4 * lane); const f32x4 gp = *(const f32x4*)(gpost + 256 * j + 4 * lane);
                x[j] = x[j] + g * (o[j] * rstd * gp); }
        }
        if (has_post || from_input) {
#pragma unroll
            for (int j = 0; j < 4; ++j) *(f32x4*)(X + (size_t)r * DM + 256 * j + 4 * lane) = x[j];
        }
        if (has_pre) {
            const float* shift = mod + ((size_t)ln * NBT + br) * NMOD + (inn * 3 + 0) * DM; const float* scale = shift + DM;
            float ss = 0.f;
#pragma unroll
            for (int j = 0; j < 4; ++j) ss += (x[j].x * x[j].x + x[j].y * x[j].y) + (x[j].z * x[j].z + x[j].w * x[j].w);
            const float rstd = rsqrtf(wave_sum(ss) * (1.0f / DM) + EPS);
#pragma unroll
            for (int j = 0; j < 4; ++j) { const f32x4 sh = *(const f32x4*)(shift + 256 * j + 4 * lane), sc = *(const f32x4*)(scale + 256 * j + 4 * lane), gp = *(const f32x4*)(gpre + 256 * j + 4 * lane);
                const f32x4 h = (x[j] * rstd * gp) * (sc + 1.0f) + sh;
                u32x2 w; w.x = pk2(h.x, h.y); w.y = pk2(h.z, h.w); *(u32x2*)(H + (size_t)r * DM + 256 * j + 4 * lane) = w; }
        }
    }
}

template <class MaskF>
DI void attn_wave32(const bf16_t* Kl, const bf16_t* VTl, int VST, const bf16x8 (&qf)[4], float sink, MaskF valid, int r32, int hi, f32x16 (&o)[2]) {
    f32x16 s[5];
#pragma unroll
    for (int j = 0; j < 5; ++j) {
#pragma unroll
        for (int i = 0; i < 16; ++i) s[j][i] = 0.f;
#pragma unroll
        for (int ds = 0; ds < 4; ++ds) { const bf16x8 a = *(const bf16x8*)(Kl + (j * 32 + r32) * 72 + 16 * ds + 8 * hi); s[j] = MFMA32(a, qf[ds], s[j]); }
    }
    float m = -1e30f;
#pragma unroll
    for (int j = 0; j < 5; ++j)
#pragma unroll
        for (int i = 0; i < 16; ++i) { const int key = j * 32 + crow(i, hi); const float v = valid(key) ? s[j][i] : -1e30f; s[j][i] = v; m = fmaxf(m, v); }
    m = fmaxf(m, __shfl_xor(m, 32)); m = fmaxf(m, sink);
    float l = 0.f;
#pragma unroll
    for (int j = 0; j < 5; ++j)
#pragma unroll
        for (int i = 0; i < 16; ++i) { const float p = __expf(s[j][i] - m); s[j][i] = p; l += p; }
    l += __shfl_xor(l, 32);
    const float inv = 1.0f / (l + __expf(sink - m));
#pragma unroll
    for (int db = 0; db < 2; ++db)
#pragma unroll
        for (int i = 0; i < 16; ++i) o[db][i] = 0.f;
#pragma unroll
    for (int j = 0; j < 5; ++j)
#pragma unroll
        for (int st = 0; st < 2; ++st) {
            u32x4 pw; pw.x = pk2(s[j][8 * st + 0] * inv, s[j][8 * st + 1] * inv); pw.y = pk2(s[j][8 * st + 2] * inv, s[j][8 * st + 3] * inv);
            pw.z = pk2(s[j][8 * st + 4] * inv, s[j][8 * st + 5] * inv); pw.w = pk2(s[j][8 * st + 6] * inv, s[j][8 * st + 7] * inv);
            const bf16x8 pf = __builtin_bit_cast(bf16x8, pw);
#pragma unroll
            for (int db = 0; db < 2; ++db) { const bf16_t* vp = VTl + (32 * db + r32) * VST + j * 32 + 16 * st + 4 * hi;
                const s16x4 lo = *(const s16x4*)vp, hi4 = *(const s16x4*)(vp + 8);
                const bf16x8 vf = __builtin_shufflevector(lo, hi4, 0, 1, 2, 3, 4, 5, 6, 7);
                o[db] = MFMA32(vf, pf, o[db]); }
        }
}
DI void attn_store(const f32x16 (&o)[2], bf16_t* dst  , int hi) {
#pragma unroll
    for (int db = 0; db < 2; ++db)
#pragma unroll
        for (int g4 = 0; g4 < 4; ++g4) { u32x2 w; w.x = pk2(o[db][4 * g4], o[db][4 * g4 + 1]); w.y = pk2(o[db][4 * g4 + 2], o[db][4 * g4 + 3]);
            *(u32x2*)(dst + 32 * db + 8 * g4 + 4 * hi) = w; }
}
DI void load_q(const bf16_t* zq, const float* cs, int hi, bf16x8 (&qf)[4]) {
#pragma unroll
    for (int ds = 0; ds < 2; ++ds) { const int d1 = 16 * ds + 8 * hi; float x1[8], x2[8], y1[8], y2[8];
        unpack8(*(const u32x4*)(zq + d1), x1); unpack8(*(const u32x4*)(zq + d1 + 32), x2);
#pragma unroll
        for (int e = 0; e < 8; ++e) { const float c = cs[2 * (d1 + e)], s = cs[2 * (d1 + e) + 1]; y1[e] = (x1[e] * c - x2[e] * s) * 0.125f; y2[e] = (x2[e] * c + x1[e] * s) * 0.125f; }
        qf[ds] = __builtin_bit_cast(bf16x8, pack8(y1)); qf[ds + 2] = __builtin_bit_cast(bf16x8, pack8(y2)); }
}

DI void attn_prompt_unit(const Args& A, int l, int u, unsigned char* lds, int tid, int lane, int wave) {
    unsigned char* ws = A.ws;
    const bf16_t* Z = (const bf16_t*)(ws + WS_BIG); bf16_t* CAT = (bf16_t*)(ws + WS_H); const float* rope = (const float*)(ws + WS_ROPE);
    const int b = u >> 6, kvh = (u >> 5) & 1, qb = u & 31, q0 = qb * 64;
    bf16_t* Kl = (bf16_t*)lds; bf16_t* VTl = (bf16_t*)(lds + 27648); constexpr int VST = 200;
    float* nk = A.out + O_KP + ((size_t)(l * NB + b) * 128) * 128 + kvh * 64; float* nv = A.out + O_VP + ((size_t)(l * NB + b) * 128) * 128 + kvh * 64;
    for (int it = tid; it < 192 * 4; it += NTHREADS) { const int key = it >> 2, o = it & 3; const int pos = q0 - 128 + key;
        float y1[8], y2[8];
        if (pos >= 0) { const bf16_t* zk = Z + (size_t)(b * SEQ + pos) * DIN + KA + kvh * 64 + 8 * o; float x1[8], x2[8];
            unpack8(*(const u32x4*)zk, x1); unpack8(*(const u32x4*)(zk + 32), x2); const float* cs = rope + (size_t)pos * 64 + 16 * o;
#pragma unroll
            for (int e = 0; e < 8; ++e) { const float c = cs[2 * e], s = cs[2 * e + 1]; y1[e] = x1[e] * c - x2[e] * s; y2[e] = x2[e] * c + x1[e] * s; }
            if (qb == 31 && key >= 64) { float* d = nk + (size_t)(key - 64) * 128 + 8 * o;
                *(f32x4*)d = (f32x4){y1[0], y1[1], y1[2], y1[3]}; *(f32x4*)(d + 4) = (f32x4){y1[4], y1[5], y1[6], y1[7]};
                *(f32x4*)(d + 32) = (f32x4){y2[0], y2[1], y2[2], y2[3]}; *(f32x4*)(d + 36) = (f32x4){y2[4], y2[5], y2[6], y2[7]}; }
        } else {
#pragma unroll
            for (int e = 0; e < 8; ++e) { y1[e] = 0.f; y2[e] = 0.f; } }
        *(u32x4*)(Kl + key * 72 + 8 * o) = pack8(y1); *(u32x4*)(Kl + key * 72 + 32 + 8 * o) = pack8(y2); }
    for (int it = tid; it < 192 * 8; it += NTHREADS) { const int key = it >> 3, o = it & 7; const int pos = q0 - 128 + key;
        u32x4 w = (u32x4){0u, 0u, 0u, 0u};
        if (pos >= 0) { w = *(const u32x4*)(Z + (size_t)(b * SEQ + pos) * DIN + VA + kvh * 64 + 8 * o);
            if (qb == 31 && key >= 64) { float x[8]; unpack8(w, x); float* d = nv + (size_t)(key - 64) * 128 + 8 * o;
                *(f32x4*)d = (f32x4){x[0], x[1], x[2], x[3]}; *(f32x4*)(d + 4) = (f32x4){x[4], x[5], x[6], x[7]}; } }
        bf16_t* vt = VTl + (8 * o) * VST + key;
        vt[0] = (bf16_t)(w.x & 0xffffu); vt[VST] = (bf16_t)(w.x >> 16); vt[2 * VST] = (bf16_t)(w.y & 0xffffu); vt[3 * VST] = (bf16_t)(w.y >> 16);
        vt[4 * VST] = (bf16_t)(w.z & 0xffffu); vt[5 * VST] = (bf16_t)(w.z >> 16); vt[6 * VST] = (bf16_t)(w.w & 0xffffu); vt[7 * VST] = (bf16_t)(w.w >> 16); }
    __syncthreads();
    {
        const int g = wave >> 1, half = wave & 1, r32 = lane & 31, hi = lane >> 5, head = kvh * 4 + g;
        const int qpos = q0 + 32 * half + r32; const size_t row = (size_t)b * SEQ + qpos;
        bf16x8 qf[4]; load_q(Z + row * DIN + QA + head * 64, rope + (size_t)qpos * 64, hi, qf);
        const float sink = A.in[16][l * 8 + head];
        const int kbase = q0 - 128 + 32 * half;
        f32x16 o[2];
        attn_wave32(Kl + half * 32 * 72, VTl + half * 32, VST, qf, sink,
                    [&](int key) { const int diff = 128 + r32 - key; return diff >= 0 && diff < 128 && (kbase + key) >= 0; }, r32, hi, o);
        attn_store(o, CAT + row * DM + head * 64, hi);
    }
    __syncthreads();
}

DI void attn_sample_unit(const Args& A, int l, int b, unsigned char* lds, int tid, int lane, int wave) {
    unsigned char* ws = A.ws;
    const bf16_t* Z = (const bf16_t*)(ws + WS_BIG); bf16_t* CAT = (bf16_t*)(ws + WS_H); const float* rope = (const float*)(ws + WS_ROPE);
    constexpr int VST = 168, KV_BYTES = 23040 + 21504;
    const float* ck = A.in[2] + ((size_t)(l * DB + b) * 128) * 128; const float* cv = A.in[3] + ((size_t)(l * DB + b) * 128) * 128;
    float* nk = A.out + O_KS + ((size_t)(l * DB + b) * 128) * 128; float* nv = A.out + O_VS + ((size_t)(l * DB + b) * 128) * 128;
    for (int it = tid; it < 2 * 160 * 4; it += NTHREADS) { const int kvh = it / 640, rr = it % 640, key = rr >> 2, o = rr & 3;
        bf16_t* Kl = (bf16_t*)(lds + kvh * KV_BYTES);
        float y1[8], y2[8];
        if (key < 128) { const float* s = ck + (size_t)key * 128 + kvh * 64 + 8 * o;
#pragma unroll
            for (int e = 0; e < 8; ++e) { y1[e] = s[e]; y2[e] = s[32 + e]; }
        } else if (key < 136) { const int i = key - 128; const bf16_t* zk = Z + (size_t)(MP + b * DS + i) * DIN + KA + kvh * 64 + 8 * o; float x1[8], x2[8];
            unpack8(*(const u32x4*)zk, x1); unpack8(*(const u32x4*)(zk + 32), x2); const float* cs = rope + (size_t)(2048 + i) * 64 + 16 * o;
#pragma unroll
            for (int e = 0; e < 8; ++e) { const float c = cs[2 * e], s = cs[2 * e + 1]; y1[e] = x1[e] * c - x2[e] * s; y2[e] = x2[e] * c + x1[e] * s; }
        } else {
#pragma unroll
            for (int e = 0; e < 8; ++e) { y1[e] = 0.f; y2[e] = 0.f; } }
        if (key >= 8 && key < 136) { float* d = nk + (size_t)(key - 8) * 128 + kvh * 64 + 8 * o;
#pragma unroll
            for (int e = 0; e < 8; ++e) { d[e] = y1[e]; d[32 + e] = y2[e]; } }
        *(u32x4*)(Kl + key * 72 + 8 * o) = pack8(y1); *(u32x4*)(Kl + key * 72 + 32 + 8 * o) = pack8(y2); }
    for (int it = tid; it < 2 * 160 * 8; it += NTHREADS) { const int kvh = it / 1280, rr = it % 1280, key = rr >> 3, o = rr & 7;
        bf16_t* VTl = (bf16_t*)(lds + kvh * KV_BYTES + 23040);
        float x[8];
        if (key < 128) { const float* s = cv + (size_t)key * 128 + kvh * 64 + 8 * o;
#pragma unroll
            for (int e = 0; e < 8; ++e) x[e] = s[e];
        } else if (key < 136) { unpack8(*(const u32x4*)(Z + (size_t)(MP + b * DS + key - 128) * DIN + VA + kvh * 64 + 8 * o), x);
        } else {
#pragma unroll
            for (int e = 0; e < 8; ++e) x[e] = 0.f; }
        if (key >= 8 && key < 136) { float* d = nv + (size_t)(key - 8) * 128 + kvh * 64 + 8 * o;
#pragma unroll
            for (int e = 0; e < 8; ++e) d[e] = x[e]; }
#pragma unroll
        for (int e = 0; e < 8; ++e) VTl[(8 * o + e) * VST + key] = (bf16_t)f2bf(x[e]); }
    __syncthreads();
    if (wave < 2) {
        const int kvh = wave, r32 = lane & 31, hi = lane >> 5, g = r32 >> 3, i = r32 & 7, head = kvh * 4 + g;
        const size_t row = (size_t)MP + b * DS + i;
        bf16x8 qf[4]; load_q(Z + row * DIN + QA + head * 64, rope + (size_t)(2048 + i) * 64, hi, qf);
        const float sink = A.in[16][l * 8 + head];
        f32x16 o[2];
        attn_wave32((const bf16_t*)(lds + kvh * KV_BYTES), (const bf16_t*)(lds + kvh * KV_BYTES + 23040), VST, qf, sink,
                    [&](int key) { return key < 128 ? (key > i) : (key < 136 && (key - 128) <= i); }, r32, hi, o);
        attn_store(o, CAT + row * DM + head * 64, hi);
    }
    __syncthreads();
}

DI float lb_val(const float* lbraw, int l, int idx) { if (l == 0) return 0.f; const float a = lbraw[idx], b = lbraw[256 + idx]; return 1.0f / (1.0f + __expf(a - b)); }

DI void hg_gates_cumsum(const bf16_t* Z, size_t row0, int h, const float* lbraw, int l, float* lf, float* kk, float* tot, int tid) {
    { const int t = tid >> 3, k0 = (tid & 7) * 8; float x[8];
      unpack8(*(const u32x4*)(Z + (row0 + t) * DIN + FH + h * 64 + k0), x);
#pragma unroll
      for (int e = 0; e < 8; ++e) { const float lbv = lb_val(lbraw, l, h * 64 + k0 + e); const float xv = fminf(fmaxf(x[e], -60.f), 60.f);
          const float f = lbv + (1.0f - lbv) * sigmoidf_(xv); lf[t * 64 + k0 + e] = __logf(f); kk[t * 64 + k0 + e] = (1.0f - lbv) * sigmoidf_(-xv); } }
    __syncthreads();
    { const int k = tid & 63, seg = tid >> 6; float run = 0.f;
#pragma unroll
      for (int i = 0; i < 8; ++i) { run += lf[(8 * seg + i) * 64 + k]; lf[(8 * seg + i) * 64 + k] = run; }
      tot[seg * 64 + k] = run;
      __syncthreads();
      float off = 0.f;
      for (int s = 0; s < seg; ++s) off += tot[s * 64 + k];
#pragma unroll
      for (int i = 0; i < 8; ++i) lf[(8 * seg + i) * 64 + k] += off; }
    __syncthreads();
}

DI void hg_pass1_unit(const Args& A, int l, int u, unsigned char* lds, int tid, int lane, int wave) {
    unsigned char* ws = A.ws; const bf16_t* Z = (const bf16_t*)(ws + WS_BIG);
    const int b = u >> 7, h = (u >> 5) & 3, c = u & 31; const size_t row0 = (size_t)b * SEQ + c * 64;
    float* lf = (float*)lds; float* kk = (float*)(lds + 16384); float* tot = (float*)(lds + 32768); bf16_t* KT = (bf16_t*)(lds + 36864); bf16_t* VT = (bf16_t*)(lds + 36864 + 9216);
    hg_gates_cumsum(Z, row0, h, A.in[17], l, lf, kk, tot, tid);
    { const int t = tid >> 3, k0 = (tid & 7) * 8;
#pragma unroll
      for (int e = 0; e < 8; ++e) { const int k = k0 + e; KT[k * 72 + t] = (bf16_t)f2bf(kk[t * 64 + k] * __expf(lf[63 * 64 + k] - lf[t * 64 + k])); }
      const u32x4 w = *(const u32x4*)(Z + (row0 + t) * DIN + IH + h * 64 + k0); bf16_t* vt = VT + k0 * 72 + t;
      vt[0] = (bf16_t)(w.x & 0xffffu); vt[72] = (bf16_t)(w.x >> 16); vt[144] = (bf16_t)(w.y & 0xffffu); vt[216] = (bf16_t)(w.y >> 16);
      vt[288] = (bf16_t)(w.z & 0xffffu); vt[360] = (bf16_t)(w.z >> 16); vt[432] = (bf16_t)(w.w & 0xffffu); vt[504] = (bf16_t)(w.w >> 16); }
    if (tid < 64) ((float*)(ws + WS_HD))[(size_t)u * 64 + tid] = __expf(lf[63 * 64 + tid]);
    __syncthreads();
    { const int kt = wave >> 1, q4 = lane >> 4, c16 = lane & 15; float* U = (float*)(ws + WS_HU) + (size_t)u * 4096;
#pragma unroll
      for (int vv = 0; vv < 2; ++vv) { const int vt = 2 * (wave & 1) + vv; f32x4 acc = (f32x4){0.f, 0.f, 0.f, 0.f};
#pragma unroll
          for (int ks = 0; ks < 2; ++ks) { const bf16x8 a = *(const bf16x8*)(KT + (16 * kt + c16) * 72 + 32 * ks + 8 * q4); const bf16x8 bb = *(const bf16x8*)(VT + (16 * vt + c16) * 72 + 32 * ks + 8 * q4);
              acc = MFMA16(a, bb, acc); }
#pragma unroll
          for (int e = 0; e < 4; ++e) U[(16 * kt + 4 * q4 + e) * 64 + 16 * vt + c16] = acc[e]; } }
    __syncthreads();
}

DI void hg_scan_unit(const Args& A, int l, int u, int tid) {
    unsigned char* ws = A.ws; const int b = u >> 2, h = u & 3;
    float* U = (float*)(ws + WS_HU) + ((size_t)(b * 4 + h) * 32) * 4096; const float* D = (const float*)(ws + WS_HD) + ((size_t)(b * 4 + h) * 32) * 64;
    const int k = tid >> 3, v0 = (tid & 7) * 8;
    f32x4 s0 = (f32x4){0.f, 0.f, 0.f, 0.f}, s1 = s0;
    for (int c = 0; c < 32; ++c) { float* p = U + (size_t)c * 4096 + k * 64 + v0; const float d = D[c * 64 + k];
        const f32x4 u0 = *(const f32x4*)p, u1 = *(const f32x4*)(p + 4);
        *(f32x4*)p = s0; *(f32x4*)(p + 4) = s1;
        s0 = s0 * d + u0; s1 = s1 * d + u1; }
    float* so = A.out + O_SP + ((size_t)((l * NB + b) * 4 + h)) * 4096 + k * 64 + v0;
    *(f32x4*)so = s0; *(f32x4*)(so + 4) = s1;
}

DI void hg_pass3_unit(const Args& A, int l, int u, unsigned char* lds, int tid, int lane, int wave) {
    unsigned char* ws = A.ws; const bf16_t* Z = (const bf16_t*)(ws + WS_BIG); bf16_t* CAT = (bf16_t*)(ws + WS_H);
    const int b = u >> 7, h = (u >> 5) & 3, c = u & 31; const size_t row0 = (size_t)b * SEQ + c * 64;
    float* bb = (float*)lds; float* kk = (float*)(lds + 16384); float* qq = (float*)(lds + 32768); float* tot = (float*)(lds + 49152);
    bf16_t* VT = (bf16_t*)(lds + 53248); bf16_t* ST = (bf16_t*)(lds + 53248 + 9216); float* ssum = (float*)(lds + 53248 + 18432);
    { const int t = tid >> 3, k0 = (tid & 7) * 8; float x[8];
      unpack8(*(const u32x4*)(Z + (row0 + t) * DIN + QH + h * 64 + k0), x);
#pragma unroll
      for (int e = 0; e < 8; ++e) qq[t * 64 + k0 + e] = x[e];
      const u32x4 w = *(const u32x4*)(Z + (row0 + t) * DIN + IH + h * 64 + k0); bf16_t* vt = VT + k0 * 72 + t;
      vt[0] = (bf16_t)(w.x & 0xffffu); vt[72] = (bf16_t)(w.x >> 16); vt[144] = (bf16_t)(w.y & 0xffffu); vt[216] = (bf16_t)(w.y >> 16);
      vt[288] = (bf16_t)(w.z & 0xffffu); vt[360] = (bf16_t)(w.z >> 16); vt[432] = (bf16_t)(w.w & 0xffffu); vt[504] = (bf16_t)(w.w >> 16);
      const float* sp = (const float*)(ws + WS_HU) + (size_t)u * 4096 + t * 64 + k0; const f32x4 a0 = *(const f32x4*)sp, a1 = *(const f32x4*)(sp + 4);
      bf16_t* st = ST + k0 * 72 + t;
      st[0] = (bf16_t)f2bf(a0.x); st[72] = (bf16_t)f2bf(a0.y); st[144] = (bf16_t)f2bf(a0.z); st[216] = (bf16_t)f2bf(a0.w);
      st[288] = (bf16_t)f2bf(a1.x); st[360] = (bf16_t)f2bf(a1.y); st[432] = (bf16_t)f2bf(a1.z); st[504] = (bf16_t)f2bf(a1.w); }
    hg_gates_cumsum(Z, row0, h, A.in[17], l, bb, kk, tot, tid);
    const int ti = wave & 3, vh = wave >> 2, q4 = lane >> 4, c16 = lane & 15; const int t = 16 * ti + c16;
    float beta[16];
#pragma unroll
    for (int ks = 0; ks < 2; ++ks)
#pragma unroll
        for (int e = 0; e < 8; ++e) { const int k = 32 * ks + 8 * q4 + e; beta[ks * 8 + e] = ti > 0 ? bb[(16 * ti - 1) * 64 + k] : 0.f; }
    bf16x8 qi[2], qo[2];
#pragma unroll
    for (int ks = 0; ks < 2; ++ks) { float a[8], o8[8];
#pragma unroll
        for (int e = 0; e < 8; ++e) { const int k = 32 * ks + 8 * q4 + e; const float bt = bb[t * 64 + k], qv = qq[t * 64 + k]; a[e] = qv * __expf(bt - beta[ks * 8 + e]); o8[e] = qv * __expf(bt); }
        qi[ks] = __builtin_bit_cast(bf16x8, pack8(a)); qo[ks] = __builtin_bit_cast(bf16x8, pack8(o8)); }
    f32x4 pt[4];
#pragma unroll
    for (int j = 0; j < 4; ++j) { pt[j] = (f32x4){0.f, 0.f, 0.f, 0.f};
        if (j <= ti) { const int s = 16 * j + c16;
#pragma unroll
            for (int ks = 0; ks < 2; ++ks) { float a[8];
#pragma unroll
                for (int e = 0; e < 8; ++e) { const int k = 32 * ks + 8 * q4 + e; a[e] = kk[s * 64 + k] * __expf(beta[ks * 8 + e] - bb[s * 64 + k]); }
                pt[j] = MFMA16(__builtin_bit_cast(bf16x8, pack8(a)), qi[ks], pt[j]); }
            if (j == ti) {
#pragma unroll
                for (int e = 0; e < 4; ++e) if (4 * q4 + e > c16) pt[j][e] = 0.f; } } }
    f32x4 o[2]; float ss = 0.f;
#pragma unroll
    for (int vv = 0; vv < 2; ++vv) { const int vt = 2 * vh + vv; const int v = 16 * vt + c16; f32x4 acc = (f32x4){0.f, 0.f, 0.f, 0.f};
#pragma unroll
        for (int p = 0; p < 2; ++p) if (2 * p <= ti) {
            u32x4 pw; pw.x = pk2(pt[2 * p][0], pt[2 * p][1]); pw.y = pk2(pt[2 * p][2], pt[2 * p][3]); pw.z = pk2(pt[2 * p + 1][0], pt[2 * p + 1][1]); pw.w = pk2(pt[2 * p + 1][2], pt[2 * p + 1][3]);
            const s16x4 lo = *(const s16x4*)(VT + v * 72 + 32 * p + 4 * q4), hi4 = *(const s16x4*)(VT + v * 72 + 32 * p + 16 + 4 * q4);
            acc = MFMA16(__builtin_shufflevector(lo, hi4, 0, 1, 2, 3, 4, 5, 6, 7), __builtin_bit_cast(bf16x8, pw), acc); }
#pragma unroll
        for (int ks = 0; ks < 2; ++ks) { const bf16x8 a = *(const bf16x8*)(ST + v * 72 + 32 * ks + 8 * q4); acc = MFMA16(a, qo[ks], acc); }
        o[vv] = acc; ss += (acc[0] * acc[0] + acc[1] * acc[1]) + (acc[2] * acc[2] + acc[3] * acc[3]); }
    ss += __shfl_xor(ss, 16); ss += __shfl_xor(ss, 32);
    if (q4 == 0) ssum[vh * 64 + t] = ss;
    __syncthreads();
    { const float rstd = rsqrtf((ssum[t] + ssum[64 + t]) * (1.0f / 64.0f) + EPS); const float* gn = A.in[18] + l * 64;
#pragma unroll
      for (int vv = 0; vv < 2; ++vv) { const int v0 = 16 * (2 * vh + vv) + 4 * q4; const u32x2 gw = *(const u32x2*)(Z + (row0 + t) * DIN + GH + h * 64 + v0);
          const float g0 = bflo(gw.x), g1 = bfhi(gw.x), g2 = bflo(gw.y), g3 = bfhi(gw.y);
          const float r0 = o[vv][0] * rstd * gn[v0] * (g0 * sigmoidf_(g0)), r1 = o[vv][1] * rstd * gn[v0 + 1] * (g1 * sigmoidf_(g1));
          const float r2 = o[vv][2] * rstd * gn[v0 + 2] * (g2 * sigmoidf_(g2)), r3 = o[vv][3] * rstd * gn[v0 + 3] * (g3 * sigmoidf_(g3));
          u32x2 w; w.x = pk2(r0, r1); w.y = pk2(r2, r3); *(u32x2*)(CAT + (row0 + t) * DM + 512 + h * 64 + v0) = w; } }
    __syncthreads();
}

DI void hg_sample_unit(const Args& A, int l, int u, unsigned char* lds, int tid, int lane, int wave) {
    unsigned char* ws = A.ws; const bf16_t* Z = (const bf16_t*)(ws + WS_BIG); bf16_t* CAT = (bf16_t*)(ws + WS_H);
    const int b = u >> 2, h = u & 3; const size_t row0 = (size_t)MP + b * DS;
    float* fs = (float*)lds; float* ks_ = fs + 512; float* qs = fs + 1024; float* vs = fs + 1536; float* red = fs + 2048;
    { const int t = tid >> 6, k = tid & 63; const bf16_t* zr = Z + (row0 + t) * DIN + h * 64 + k;
      const float lbv = lb_val(A.in[17], l, h * 64 + k); const float xv = fminf(fmaxf(bf2f(zr[FH]), -60.f), 60.f);
      fs[tid] = lbv + (1.0f - lbv) * sigmoidf_(xv); ks_[tid] = (1.0f - lbv) * sigmoidf_(-xv); qs[tid] = bf2f(zr[QH]); vs[tid] = bf2f(zr[IH]); }
    __syncthreads();
    const int v = tid & 63, ksl = tid >> 6;
    const float* s0 = A.in[4] + ((size_t)((l * DB + b) * 4 + h)) * 4096;
    float S[8];
#pragma unroll
    for (int j = 0; j < 8; ++j) S[j] = s0[(8 * ksl + j) * 64 + v];
#pragma unroll
    for (int t = 0; t < 8; ++t) { const float vt = vs[t * 64 + v]; float po = 0.f;
#pragma unroll
        for (int j = 0; j < 8; ++j) { const int k = 8 * ksl + j; S[j] = fs[t * 64 + k] * S[j] + ks_[t * 64 + k] * vt; po += S[j] * qs[t * 64 + k]; }
        red[(t * 8 + ksl) * 64 + v] = po; }
    float* so = A.out + O_SS + ((size_t)((l * DB + b) * 4 + h)) * 4096;
#pragma unroll
    for (int j = 0; j < 8; ++j) so[(8 * ksl + j) * 64 + v] = S[j];
    __syncthreads();
    { const int t = tid >> 6; float o = 0.f;
#pragma unroll
      for (int s = 0; s < 8; ++s) o += red[(t * 8 + s) * 64 + v];
      const float rstd = rsqrtf(wave_sum(o * o) * (1.0f / 64.0f) + EPS);
      const float g = bf2f(Z[(row0 + t) * DIN + GH + h * 64 + v]);
      CAT[(row0 + t) * DM + 512 + h * 64 + v] = (bf16_t)f2bf(o * rstd * A.in[18][l * 64 + v] * (g * sigmoidf_(g))); }
    __syncthreads();
}

DI void conv_unit(const Args& A, int l, int u, int tid) {
    unsigned char* ws = A.ws; const bf16_t* Z = (const bf16_t*)(ws + WS_BIG); bf16_t* CAT = (bf16_t*)(ws + WS_H);
    const int r = u * 16 + (tid >> 5), c0 = (tid & 31) * 8;
    int t, T, b; bool samp = r >= MP;
    if (!samp) { b = r >> 11; t = r & 2047; T = SEQ; } else { b = (r - MP) >> 3; t = (r - MP) & 7; T = DS; }
    float u0[8], u1[8], u2[8], bc[8], x[8], y[8];
    { const bf16_t* z = Z + (size_t)r * DIN; unpack8(*(const u32x4*)(z + CC + c0), x); unpack8(*(const u32x4*)(z + HC + c0), y); unpack8(*(const u32x4*)(z + BC + c0), bc);
#pragma unroll
      for (int e = 0; e < 8; ++e) u2[e] = x[e] * y[e]; }
    if (t >= 1) { const bf16_t* z = Z + (size_t)(r - 1) * DIN; unpack8(*(const u32x4*)(z + CC + c0), x); unpack8(*(const u32x4*)(z + HC + c0), y);
#pragma unroll
        for (int e = 0; e < 8; ++e) u1[e] = x[e] * y[e];
    } else {
#pragma unroll
        for (int e = 0; e < 8; ++e) u1[e] = samp ? A.in[5][((size_t)(l * DB + b) * 2 + 1) * 256 + c0 + e] : 0.f; }
    if (t >= 2) { const bf16_t* z = Z + (size_t)(r - 2) * DIN; unpack8(*(const u32x4*)(z + CC + c0), x); unpack8(*(const u32x4*)(z + HC + c0), y);
#pragma unroll
        for (int e = 0; e < 8; ++e) u0[e] = x[e] * y[e];
    } else {
#pragma unroll
        for (int e = 0; e < 8; ++e) u0[e] = samp ? A.in[5][((size_t)(l * DB + b) * 2 + t) * 256 + c0 + e] : 0.f; }
    const float* cw = A.in[19] + (size_t)l * 3 * 256 + c0; float o[8];
#pragma unroll
    for (int e = 0; e < 8; ++e) o[e] = bc[e] * (u0[e] * cw[e] + u1[e] * cw[256 + e] + u2[e] * cw[512 + e]);
    *(u32x4*)(CAT + (size_t)r * DM + 768 + c0) = pack8(o);
    if (t >= T - 2) { float* d = samp ? A.out + O_CS + ((size_t)(l * DB + b) * 2 + (t - (T - 2))) * 256 + c0 : A.out + O_CP + ((size_t)(l * NB + b) * 2 + (t - (T - 2))) * 256 + c0;
#pragma unroll
        for (int e = 0; e < 8; ++e) d[e] = u2[e]; }
}

__global__ void __launch_bounds__(NTHREADS, 2) hymba_fwd(Args A_unused) {
    extern __shared__ __attribute__((aligned(16))) unsigned char lds[];
    cg::grid_group grid = cg::this_grid();
    LAS unsigned char* ldsl = (LAS unsigned char*)lds;
#define LOADARGS() const __attribute__((address_space(4))) Args* ap_ = (const __attribute__((address_space(4))) Args*)__builtin_amdgcn_kernarg_segment_ptr(); asm volatile("" : "+s"(ap_)); Args A; _Pragma("unroll") for (int i_ = 0; i_ < 20; ++i_) A.in[i_] = ap_->in[i_]; A.out = ap_->out; A.ws = ap_->ws; unsigned char* ws = A.ws; (void)ws; int tid = threadIdx.x; asm volatile("" : "+v"(tid)); const int lane = tid & 63, wave = __builtin_amdgcn_readfirstlane(tid >> 6); (void)lane; (void)wave
#define GSYNC() grid.sync()

#ifndef SKIP_P0
    { LOADARGS(); p0_prologue(A, lds, tid, lane, wave); }
#endif
    GSYNC();
    { LOADARGS(); pg8::Gemm g{(const pg8::bf16_t*)(ws + WS_AMOD), (const pg8::bf16_t*)(ws + WS_WADA), 256, 2 * NMOD, DM}; pg8::StaticOrder S; S.init(256, 2 * NMOD, gridDim.x, blockIdx.x);
      pg8::EpiModF32 E{(float*)(ws + WS_MOD), A.in[9], NBT, NMOD};

#ifndef SKIP_G1
      pg8::gemm_phase<pg8::EpiModF32, pg8::StaticOrder, true, true>(ldsl, g, S, E);
#endif
 }
    GSYNC();

#ifndef SKIP_R1
    { LOADARGS(); row_pass(A, false, 0, 0, 0.f, true, 0, 0, true, lane, wave); }
#endif

    GSYNC();
    for (int l = 0; l < NL; ++l) {
        for (int f = 0; f < 2; ++f) {
            if (f == 1) {
                { LOADARGS(); pg8::Gemm g{(const pg8::bf16_t*)(ws + WS_H), (const pg8::bf16_t*)(ws + WS_WMIN) + (size_t)l * DIN * DM, MT, DIN, DM}; pg8::StaticOrder S; S.init(MT, DIN, gridDim.x, blockIdx.x);
                  pg8::EpiBf16 E{(pg8::bf16_t*)(ws + WS_BIG), DIN};

#ifndef SKIP_G2
                  pg8::gemm_phase<pg8::EpiBf16, pg8::StaticOrder, true, true>(ldsl, g, S, E);
#endif
 }
                GSYNC();
                for (int u = blockIdx.x; u < 2048 + 2112 + 512; u += gridDim.x) { LOADARGS();
#ifndef SKIP_HP1
                    if (u < 2048) hg_pass1_unit(A, l, u, lds, tid, lane, wave);
#endif
#ifndef SKIP_CONV
                    if (u >= 2048 && u < 2048 + 2112) conv_unit(A, l, u - 2048, tid);
#endif
#ifndef SKIP_HS
                    if (u >= 2048 + 2112) hg_sample_unit(A, l, u - 2048 - 2112, lds, tid, lane, wave);
#endif
                }
                GSYNC();
                for (int u = blockIdx.x; u < 64 + 1024 + 128; u += gridDim.x) { LOADARGS();
#ifndef SKIP_SCAN
                    if (u < 64) hg_scan_unit(A, l, u, tid);
#endif
#ifndef SKIP_AP
                    if (u >= 64 && u < 64 + 1024) attn_prompt_unit(A, l, u - 64, lds, tid, lane, wave);
#endif
#ifndef SKIP_AS
                    if (u >= 64 + 1024) attn_sample_unit(A, l, u - 64 - 1024, lds, tid, lane, wave);
#endif
                }
                GSYNC();
#ifndef SKIP_HP3
                for (int u = blockIdx.x; u < 2048; u += gridDim.x) { LOADARGS(); hg_pass3_unit(A, l, u, lds, tid, lane, wave); }
#endif
                GSYNC();
                { LOADARGS(); pg8::Gemm g{(const pg8::bf16_t*)(ws + WS_H), (const pg8::bf16_t*)(ws + WS_WMOUT) + (size_t)l * DM * DM, MT, DM, DM}; pg8::StaticOrder S; S.init(MT, DM, gridDim.x, blockIdx.x);
                  pg8::EpiBf16 E{(pg8::bf16_t*)(ws + WS_OUT), DM};

#ifndef SKIP_G3
                  pg8::gemm_phase<pg8::EpiBf16, pg8::StaticOrder, true, true>(ldsl, g, S, E);
#endif
 }
                GSYNC();

#ifndef SKIP_R2
                { LOADARGS(); row_pass(A, true, l, 1, 1.0f, true, l, 2, false, lane, wave); }
#endif

                GSYNC();
            }
            { LOADARGS(); pg8::Gemm g{(const pg8::bf16_t*)(ws + WS_H), (const pg8::bf16_t*)(ws + WS_WIN) + (size_t)(l * 2 + f) * 2 * DFF * DM, MT, 2 * DFF, DM}; pg8::StaticOrder S; S.init(MT, 2 * DFF, gridDim.x, blockIdx.x);
              pg8::EpiSwiGLU E{(pg8::bf16_t*)(ws + WS_BIG), DFF};

#ifndef SKIP_G4
              pg8::gemm_phase<pg8::EpiSwiGLU, pg8::StaticOrder, true, true>(ldsl, g, S, E);
#endif
 }
            GSYNC();
            { LOADARGS(); pg8::Gemm g{(const pg8::bf16_t*)(ws + WS_BIG), (const pg8::bf16_t*)(ws + WS_WOUT) + (size_t)(l * 2 + f) * DM * DFF, MT, DM, DFF}; pg8::StaticOrder S; S.init(MT, DM, gridDim.x, blockIdx.x);
              pg8::EpiBf16 E{(pg8::bf16_t*)(ws + WS_OUT), DM};

#ifndef SKIP_G5
              pg8::gemm_phase<pg8::EpiBf16, pg8::StaticOrder, true, true>(ldsl, g, S, E);
#endif
 }
            GSYNC();

#ifndef SKIP_R3
            if (f == 0) { LOADARGS(); row_pass(A, true, l, 0, 0.5f, true, l, 1, false, lane, wave); }
#endif


#ifndef SKIP_R4
            if (f == 1) { LOADARGS(); row_pass(A, true, l, 2, 0.5f, l + 1 < NL, l + 1, 0, false, lane, wave); }
#endif

            GSYNC();
        }
    }
}

extern "C" void kernel_launch(void* const* d_in, const int* in_sizes, int n_in, void* d_out, int out_size, void* d_ws, size_t ws_size, hipStream_t stream) {
    static int grid = 0;
    if (grid == 0) {
        if (n_in != 20 || (size_t)out_size != O_END || ws_size < WS_END) { fprintf(stderr, "kernel_launch: unexpected sizes n_in %d out %d ws %zu\n", n_in, out_size, ws_size); grid = -1; return; }
        int dev = 0, cus = 0, per_cu = 0;
        hipGetDevice(&dev); hipDeviceGetAttribute(&cus, hipDeviceAttributeMultiprocessorCount, dev);
        if (hipFuncSetAttribute((const void*)hymba_fwd, hipFuncAttributeMaxDynamicSharedMemorySize, LDS_BYTES) != hipSuccess) { fprintf(stderr, "kernel_launch: hipFuncSetAttribute failed\n"); grid = -1; return; }
        if (hipOccupancyMaxActiveBlocksPerMultiprocessor(&per_cu, (const void*)hymba_fwd, NTHREADS, LDS_BYTES) != hipSuccess || per_cu < 1) { fprintf(stderr, "kernel_launch: occupancy query says %d\n", per_cu); (void)hipGetLastError(); }
        grid = cus;
    }
    if (grid < 0) return;
    Args a{};
    for (int i = 0; i < 20; ++i) a.in[i] = (const float*)d_in[i];
    a.out = (float*)d_out; a.ws = (unsigned char*)d_ws;
    void* args[] = {&a};
    hipError_t e = hipLaunchCooperativeKernel((const void*)hymba_fwd, dim3(grid), dim3(NTHREADS), args, LDS_BYTES, stream);
    if (e != hipSuccess) fprintf(stderr, "cooperative launch failed: %s (grid %d)\n", hipGetErrorString(e), grid);
}
```

```cpp
#include <hip/hip_runtime.h>
#include <hip/hip_cooperative_groups.h>
#include <cstdio>
#include <cstdint>
namespace cg = cooperative_groups;
namespace pg8 {
#define PG8_LAS __attribute__((address_space(3)))
typedef unsigned short bf16_t;
typedef short bf16x8 __attribute__((ext_vector_type(8)));
typedef float f32x4 __attribute__((ext_vector_type(4)));
typedef unsigned u32x4 __attribute__((ext_vector_type(4)));
constexpr int BM = 256, BK = 64, HALF = 128, HTB = HALF * BK * 2  , STAGE_BYTES = 8 * HTB, NXCD = 8, WGM = 8;

__host__ __device__ __forceinline__ int lds_byte(int r, int c) { const int st = (r >> 4) * 2 + (c >> 5), rr = r & 15, cc = c & 31, ob = rr * 64 + cc * 2; return st * 1024 + (ob ^ (((ob >> 9) & 1) << 5)); }
__host__ __device__ __forceinline__ void stage_rc(int b, int& R, int& C) { const int st = b / 1024, sb = b % 1024, swz = sb ^ (((sb >> 9) & 1) << 5); R = (st >> 1) * 16 + swz / 64; C = (st & 1) * 32 + (swz % 64) / 2; }
__host__ __device__ __forceinline__ int perm32(int rho) { const int n = rho >> 4, i = rho & 15; return 8 * (i >> 2) + 4 * n + (i & 3); }

struct Unit { int pm, pn; };
struct Gemm { const bf16_t* A; const bf16_t* Bt; int M, N, K; };

struct StaticOrder {
    int nM, nN, nwg, G, c;
    __host__ __device__ void init(int M, int N, int G_, int c_) { nM = M / BM; nN = N / BM; nwg = nM * nN; G = G_; c = c_; }
    __host__ __device__ bool next(int i, Unit& u) const {
        const long L = (long)i * G + c; if (L >= nwg) return false;
        int wgid = (int)L; { const int q = nwg / NXCD, r = nwg % NXCD, xcd = wgid % NXCD, off = wgid / NXCD; wgid = (xcd < r ? xcd * (q + 1) : r * (q + 1) + (xcd - r) * q) + off; }
        const int nig = WGM * nN, gid = wgid / nig, fm = gid * WGM, gsz = (nM - fm) < WGM ? (nM - fm) : WGM;
        u.pm = fm + ((wgid % nig) % gsz); u.pn = (wgid % nig) / gsz; return true;
    }
    __device__ __forceinline__ void a_ready(const Unit&) const {}
    __device__ __forceinline__ void done(const Unit&) const {}
};

__device__ __forceinline__ unsigned cvt_pk_bf16(float lo, float hi) { unsigned r; asm volatile("v_cvt_pk_bf16_f32 %0, %1, %2" : "=v"(r) : "v"(lo), "v"(hi)); return r; }
typedef float f32x2 __attribute__((ext_vector_type(2)));
struct EpiBf16 {
    static constexpr bool PERM = true, AFTER_DRAIN = false;
    bf16_t* O; int ldc;
    __device__ __forceinline__ void operator()(const f32x4 (&acc)[2][2][4][2], const Unit& u, int wr, int wc, int fr, int fq) const {
        const int row0 = u.pm * BM + wr * 64 + fr; const int col0 = u.pn * BM + wc * 32 + 8 * fq;
#pragma unroll
        for (int ai = 0; ai < 2; ++ai)
#pragma unroll
            for (int m = 0; m < 4; ++m) { bf16_t* rowp = O + (size_t)(row0 + ai * HALF + m * 16) * ldc + col0;
#pragma unroll
                for (int bj = 0; bj < 2; ++bj) { const f32x4 v0 = acc[ai][bj][m][0], v1 = acc[ai][bj][m][1];
                    u32x4 w; w.x = cvt_pk_bf16(v0[0], v0[1]); w.y = cvt_pk_bf16(v0[2], v0[3]); w.z = cvt_pk_bf16(v1[0], v1[1]); w.w = cvt_pk_bf16(v1[2], v1[3]);
                    *(u32x4*)(rowp + bj * HALF) = w; } }
    }
};
struct EpiSwiGLU {
    static constexpr bool PERM = true, AFTER_DRAIN = false;
    bf16_t* O; int ldc;
    __device__ __forceinline__ void operator()(const f32x4 (&acc)[2][2][4][2], const Unit& u, int wr, int wc, int fr, int fq) const {
        const int row0 = u.pm * BM + wr * 64 + fr; const int col0 = u.pn * HALF + wc * 32 + 8 * fq;
#pragma unroll
        for (int ai = 0; ai < 2; ++ai)
#pragma unroll
            for (int m = 0; m < 4; ++m) { bf16_t* rowp = O + (size_t)(row0 + ai * HALF + m * 16) * ldc + col0;
                float r[8];
#pragma unroll
                for (int n = 0; n < 2; ++n)
#pragma unroll
                    for (int e = 0; e < 4; ++e) { const float g = acc[ai][0][m][n][e], up = acc[ai][1][m][n][e];
                        r[n * 4 + e] = g * __builtin_amdgcn_rcpf(1.0f + __expf(-g)) * up; }
                u32x4 w; w.x = cvt_pk_bf16(r[0], r[1]); w.y = cvt_pk_bf16(r[2], r[3]); w.z = cvt_pk_bf16(r[4], r[5]); w.w = cvt_pk_bf16(r[6], r[7]);
                *(u32x4*)rowp = w; }
    }
};
struct EpiModF32 {
    static constexpr bool PERM = false, AFTER_DRAIN = false;
    float* O; const float* bias; int nrows; int ncols_l;
    __device__ __forceinline__ void operator()(const f32x4 (&acc)[2][2][4][2], const Unit& u, int wr, int wc, int fr, int fq) const {
        const int colt = u.pn * BM + wc * 32 + 4 * fq;
#pragma unroll
        for (int ai = 0; ai < 2; ++ai)
#pragma unroll
            for (int m = 0; m < 4; ++m) { const int r = u.pm * BM + ai * HALF + wr * 64 + m * 16 + fr;
                if (r < nrows) {
#pragma unroll
                    for (int bj = 0; bj < 2; ++bj)
#pragma unroll
                        for (int n = 0; n < 2; ++n) { const int c = colt + bj * HALF + n * 16; const int l = c / ncols_l, cc = c - l * ncols_l;
                            const f32x4 bv = *(const f32x4*)(bias + c);
                            *(f32x4*)(O + ((size_t)l * nrows + r) * ncols_l + cc) = acc[ai][bj][m][n] + bv; } } }
    }
};
template <class Epi, class Sched, bool ALIGN_EPI = false, bool SP2 = false>
__device__ __forceinline__ void gemm_phase(PG8_LAS unsigned char* lds, const Gemm g, const Sched& S, const Epi& E) {
    const int tid = threadIdx.x, wid = __builtin_amdgcn_readfirstlane(tid >> 6), lane = tid & 63, wr = wid >> 2, wc = wid & 3, fr = lane & 15, fq = lane >> 4;
    const int K = g.K, nt = K / BK;
    unsigned voffA[2], voffB[2];
#pragma unroll
    for (int i = 0; i < 2; ++i) { int R, C; stage_rc(tid * 16 + i * 8192, R, C); const int Rb = Epi::PERM ? ((R & ~31) + perm32(R & 31)) : R;
        voffA[i] = (unsigned)(R * K + C) * 2u; voffB[i] = (unsigned)(Rb * K + C) * 2u; }
    const size_t kstep = (size_t)(BK * 2);
    const size_t hstep = (size_t)HALF * K * 2;
    const size_t tstep = 2 * hstep;
    const unsigned ldsw = (unsigned)wid * 1024u;
    const int aoff = lds_byte(wr * 64 + fr, fq * 8), boff = lds_byte(wc * 32 + fr, fq * 8);
#define PG8_SA(b, h) (((b) * 2 + (h)) * HTB)
#define PG8_SB(b, h) ((4 + (b) * 2 + (h)) * HTB)
#define PG8_STAGE(bufoff, gbase, voff) do { _Pragma("unroll") for (int _i = 0; _i < 2; ++_i) \
        __builtin_amdgcn_global_load_lds((const unsigned*)((const char*)(gbase) + (voff)[_i]), (PG8_LAS unsigned*)(lds + (bufoff) + ldsw + _i * 8192), 16, 0, 0); } while (0)
#define PG8_LDA(dst, b, h) do { _Pragma("unroll") for (int m = 0; m < 4; ++m) _Pragma("unroll") for (int k = 0; k < 2; ++k) dst[m][k] = *(const PG8_LAS bf16x8*)(lds + PG8_SA(b, h) + aoff + m * 2048 + k * 1024); } while (0)
#define PG8_LDB(dst, b, h) do { _Pragma("unroll") for (int n = 0; n < 2; ++n) _Pragma("unroll") for (int k = 0; k < 2; ++k) dst[n][k] = *(const PG8_LAS bf16x8*)(lds + PG8_SB(b, h) + boff + n * 2048 + k * 1024); } while (0)
#define PG8_MMA(ai, bj, At, Bt) do { __builtin_amdgcn_s_setprio(1); _Pragma("unroll") for (int m = 0; m < 4; ++m) _Pragma("unroll") for (int n = 0; n < 2; ++n) _Pragma("unroll") for (int k = 0; k < 2; ++k) \
        acc[ai][bj][m][n] = __builtin_amdgcn_mfma_f32_16x16x32_bf16(Bt[n][k], At[m][k], acc[ai][bj][m][n], 0, 0, 0); __builtin_amdgcn_s_setprio(0); } while (0)
#define PG8_WAIT_V(n) asm volatile("s_waitcnt vmcnt(" #n ")" ::: "memory")
#define PG8_WAIT_L(n) asm volatile("s_waitcnt lgkmcnt(" #n ")" ::: "memory")
#define PG8_BAR __builtin_amdgcn_s_barrier()
#define PG8_SCHED __builtin_amdgcn_sched_barrier(0)
    Unit cur, nxt; int ui = 0;
    if (!S.next(0, cur)) return;
    f32x4 acc[2][2][4][2];
#pragma unroll
    for (int a = 0; a < 2; ++a)
#pragma unroll
        for (int b = 0; b < 2; ++b)
#pragma unroll
            for (int m = 0; m < 4; ++m)
#pragma unroll
                for (int n = 0; n < 2; ++n) acc[a][b][m][n] = (f32x4){0.f, 0.f, 0.f, 0.f};
    bf16x8 At[4][2], B0[2][2], B1[2][2];
    const char* cA = (const char*)g.A + (size_t)cur.pm * tstep; const char* cB = (const char*)g.Bt + (size_t)cur.pn * tstep;
    S.a_ready(cur);
    if constexpr (SP2) {
        PG8_STAGE(PG8_SB(0, 0), cB, voffB); PG8_STAGE(PG8_SB(0, 1), cB + hstep, voffB); PG8_STAGE(PG8_SA(0, 0), cA, voffA); PG8_STAGE(PG8_SA(0, 1), cA + hstep, voffA);
        if (wr == 1) PG8_BAR;
        PG8_WAIT_V(2); PG8_BAR;
        PG8_STAGE(PG8_SB(1, 0), cB + kstep, voffB); PG8_STAGE(PG8_SA(1, 0), cA + kstep, voffA); PG8_STAGE(PG8_SB(1, 1), cB + hstep + kstep, voffB);
        PG8_WAIT_V(6); PG8_BAR;
    } else {
        PG8_STAGE(PG8_SB(0, 0), cB, voffB); PG8_STAGE(PG8_SA(0, 0), cA, voffA); PG8_STAGE(PG8_SB(0, 1), cB + hstep, voffB); PG8_STAGE(PG8_SA(0, 1), cA + hstep, voffA);
        if (wr == 1) PG8_BAR;
        PG8_WAIT_V(4); PG8_BAR;
        PG8_STAGE(PG8_SB(1, 0), cB + kstep, voffB); PG8_STAGE(PG8_SA(1, 0), cA + kstep, voffA); PG8_STAGE(PG8_SB(1, 1), cB + hstep + kstep, voffB);
        PG8_WAIT_V(6); PG8_BAR;
    }
    for (;;) {
        const bool has_next = S.next(ui + 1, nxt);
        const char* nA = has_next ? (const char*)g.A + (size_t)nxt.pm * tstep : cA; const char* nB = has_next ? (const char*)g.Bt + (size_t)nxt.pn * tstep : cB;
        for (int t = 0; t < nt; t += 2) {
            const bool last = (t == nt - 2);
            const char* a1 = cA + (size_t)(t + 1) * kstep;
            const char* a2 = last ? nA : cA + (size_t)(t + 2) * kstep; const char* b2 = last ? nB : cB + (size_t)(t + 2) * kstep;
            const char* a3 = a2 + kstep; const char* b3 = b2 + kstep;
            if (last && has_next) S.a_ready(nxt);
            if constexpr (SP2) {
            PG8_LDB(B0, 0, 0); PG8_LDB(B1, 0, 1); PG8_SCHED; PG8_LDA(At, 0, 0); PG8_STAGE(PG8_SA(1, 1), a1 + hstep, voffA);
            PG8_WAIT_V(8); PG8_WAIT_L(0); PG8_BAR; PG8_MMA(0, 0, At, B0); PG8_MMA(0, 1, At, B1); PG8_BAR; PG8_SCHED;
            PG8_LDA(At, 0, 1); PG8_STAGE(PG8_SB(0, 0), b2, voffB); PG8_STAGE(PG8_SB(0, 1), b2 + hstep, voffB); PG8_STAGE(PG8_SA(0, 0), a2, voffA);
            PG8_WAIT_V(8); PG8_WAIT_L(0); PG8_BAR; PG8_MMA(1, 0, At, B0); PG8_MMA(1, 1, At, B1); PG8_BAR; PG8_SCHED;
            PG8_LDB(B0, 1, 0); PG8_LDB(B1, 1, 1); PG8_SCHED; PG8_LDA(At, 1, 0); PG8_STAGE(PG8_SA(0, 1), a2 + hstep, voffA);
            PG8_WAIT_V(8); PG8_WAIT_L(0); PG8_BAR; PG8_MMA(0, 0, At, B0); PG8_MMA(0, 1, At, B1); PG8_BAR; PG8_SCHED;
            PG8_LDA(At, 1, 1); PG8_STAGE(PG8_SB(1, 0), b3, voffB); PG8_STAGE(PG8_SB(1, 1), b3 + hstep, voffB); PG8_STAGE(PG8_SA(1, 0), a3, voffA);
            PG8_WAIT_V(8); PG8_WAIT_L(0); PG8_BAR; PG8_MMA(1, 0, At, B0); PG8_MMA(1, 1, At, B1); PG8_BAR; PG8_SCHED;
            } else {
            PG8_LDB(B0, 0, 0); PG8_SCHED; PG8_LDA(At, 0, 0); PG8_STAGE(PG8_SA(1, 1), a1 + hstep, voffA);
            PG8_WAIT_L(8); PG8_BAR; PG8_WAIT_L(0); PG8_MMA(0, 0, At, B0); PG8_BAR; PG8_SCHED;
            PG8_LDB(B1, 0, 1); PG8_STAGE(PG8_SB(0, 0), b2, voffB);
            PG8_BAR; PG8_WAIT_L(0); PG8_MMA(0, 1, At, B1); PG8_BAR;
            PG8_LDA(At, 0, 1); PG8_STAGE(PG8_SA(0, 0), a2, voffA);
            PG8_BAR; PG8_WAIT_L(0); PG8_MMA(1, 0, At, B0); PG8_BAR; PG8_SCHED;
            PG8_STAGE(PG8_SB(0, 1), b2 + hstep, voffB);
            PG8_WAIT_V(6); PG8_BAR; PG8_MMA(1, 1, At, B1); PG8_BAR;
            PG8_LDB(B0, 1, 0); PG8_SCHED; PG8_LDA(At, 1, 0); PG8_STAGE(PG8_SA(0, 1), a2 + hstep, voffA);
            PG8_WAIT_L(8); PG8_BAR; PG8_WAIT_L(0); PG8_MMA(0, 0, At, B0); PG8_BAR; PG8_SCHED;
            PG8_LDB(B1, 1, 1); PG8_STAGE(PG8_SB(1, 0), b3, voffB);
            PG8_BAR; PG8_WAIT_L(0); PG8_MMA(0, 1, At, B1); PG8_BAR;
            PG8_LDA(At, 1, 1); PG8_STAGE(PG8_SA(1, 0), a3, voffA);
            PG8_BAR; PG8_WAIT_L(0); PG8_MMA(1, 0, At, B0); PG8_BAR; PG8_SCHED;
            PG8_STAGE(PG8_SB(1, 1), b3 + hstep, voffB);
            PG8_WAIT_V(6); PG8_BAR; PG8_MMA(1, 1, At, B1); PG8_BAR;
            }
        }
        if constexpr (ALIGN_EPI) { if (wr == 0) PG8_BAR; }
        if constexpr (!Epi::AFTER_DRAIN) { E(acc, cur, wr, wc, fr, fq); S.done(cur); }
        if (!has_next) break;
#pragma unroll
        for (int a = 0; a < 2; ++a)
#pragma unroll
            for (int b = 0; b < 2; ++b)
#pragma unroll
                for (int m = 0; m < 4; ++m)
#pragma unroll
                    for (int n = 0; n < 2; ++n) acc[a][b][m][n] = (f32x4){0.f, 0.f, 0.f, 0.f};
        cur = nxt; cA = nA; cB = nB; ++ui;
        if constexpr (ALIGN_EPI) { if (wr == 1) PG8_BAR; }
    }
    PG8_WAIT_V(0);
    if constexpr (!ALIGN_EPI) { if (wr == 0) PG8_BAR; }
    PG8_BAR;
    if constexpr (Epi::AFTER_DRAIN) { E.fused(acc, cur, wr, wc, fr, fq, lds, wid, lane); S.done(cur); }
#undef PG8_SA
#undef PG8_SB
#undef PG8_STAGE
#undef PG8_LDA
#undef PG8_LDB
#undef PG8_MMA
#undef PG8_WAIT_V
#undef PG8_WAIT_L
#undef PG8_BAR
#undef PG8_SCHED
}
}
typedef unsigned short bf16_t;
typedef short bf16x8 __attribute__((ext_vector_type(8)));
typedef short s16x4 __attribute__((ext_vector_type(4)));
typedef float f32x4 __attribute__((ext_vector_type(4)));
typedef float f32x16 __attribute__((ext_vector_type(16)));
typedef unsigned u32x4 __attribute__((ext_vector_type(4)));
typedef unsigned u32x2 __attribute__((ext_vector_type(2)));
#define LAS __attribute__((address_space(3)))
#define DI __device__ __forceinline__

constexpr int DM = 1024, NB = 16, SEQ = 2048, NL = 2, DB = 128, DS = 8, PAST = 16384;
constexpr int MP = NB * SEQ, MS = DB * DS, MT = MP + MS;
constexpr int DIN = 2560, DFF = 2816, NBT = NB + DB, NMOD = 9 * DM;
constexpr int QA = 0, KA = 512, VA = 640, QH = 768, FH = 1024, IH = 1280, GH = 1536, BC = 1792, CC = 2048, HC = 2304;
constexpr float EPS = 1e-6f;
constexpr int NTHREADS = 512;
constexpr int LDS_BYTES = 147456;

constexpr size_t MiB = 1u << 20;
constexpr size_t WS_MOD = 0;
constexpr size_t WS_ROPE = 11 * MiB;
constexpr size_t WS_CTL = 11 * MiB + 768 * 1024, CTL_BYTES = 65536;
constexpr size_t WS_AMOD = 12 * MiB;
constexpr size_t WS_WADA = 13 * MiB;
constexpr size_t WS_WIN = 49 * MiB;
constexpr size_t WS_WOUT = 93 * MiB;
constexpr size_t WS_WMIN = 115 * MiB;
constexpr size_t WS_WMOUT = 125 * MiB;
constexpr size_t WS_H = 129 * MiB;
constexpr size_t WS_BIG = 195 * MiB;
constexpr size_t WS_OUT = 377 * MiB;
constexpr size_t WS_END = 443 * MiB;
constexpr size_t WS_HU = WS_OUT;
constexpr size_t WS_HD = WS_OUT + 32 * MiB;

constexpr size_t O_X = 0;
constexpr size_t O_KP = (size_t)MT * DM;
constexpr size_t O_VP = O_KP + 524288;
constexpr size_t O_SP = O_VP + 524288;
constexpr size_t O_CP = O_SP + 524288;
constexpr size_t O_KS = O_CP + 16384;
constexpr size_t O_VS = O_KS + 4194304;
constexpr size_t O_SS = O_VS + 4194304;
constexpr size_t O_CS = O_SS + 4194304;
constexpr size_t O_END = O_CS + 131072;

struct Args { const float* in[20]; float* out; unsigned char* ws; };

DI unsigned f2bf(float f) { unsigned u = __float_as_uint(f); return (u + 0x7fffu + ((u >> 16) & 1u)) >> 16; }
DI unsigned pk2(float lo, float hi) { return f2bf(lo) | (f2bf(hi) << 16); }
DI float bflo(unsigned w) { return __uint_as_float(w << 16); }
DI float bfhi(unsigned w) { return __uint_as_float(w & 0xffff0000u); }
DI float bf2f(bf16_t b) { return __uint_as_float((unsigned)b << 16); }
DI void unpack8(const u32x4 w, float (&x)[8]) { x[0] = bflo(w.x); x[1] = bfhi(w.x); x[2] = bflo(w.y); x[3] = bfhi(w.y); x[4] = bflo(w.z); x[5] = bfhi(w.z); x[6] = bflo(w.w); x[7] = bfhi(w.w); }
DI u32x4 pack8(const float (&x)[8]) { u32x4 w; w.x = pk2(x[0], x[1]); w.y = pk2(x[2], x[3]); w.z = pk2(x[4], x[5]); w.w = pk2(x[6], x[7]); return w; }
DI float sigmoidf_(float x) { return __builtin_amdgcn_rcpf(1.0f + __expf(-x)); }
DI float wave_sum(float v) {
#pragma unroll
    for (int o = 1; o < 64; o <<= 1) v += __shfl_xor(v, o);
    return v;
}
DI int crow(int r, int hi) { return (r & 3) + 8 * (r >> 2) + 4 * hi; }
#define MFMA32(a, b, c) __builtin_amdgcn_mfma_f32_32x32x16_bf16((a), (b), (c), 0, 0, 0)
#define MFMA16(a, b, c) __builtin_amdgcn_mfma_f32_16x16x32_bf16((a), (b), (c), 0, 0, 0)

DI int mod_row(int r) { return r < MP ? (r >> 11) : NB + ((r - MP) >> 3); }

DI void transpose_item(const float* W, int K, int N, bf16_t* WT, int k0, int n0, int drow0, float* scr, int lane) {
#pragma unroll 8
    for (int i = 0; i < 32; ++i) { const int kk = 2 * i + (lane >> 5); scr[kk * 33 + (lane & 31)] = W[(size_t)(k0 + kk) * N + n0 + (lane & 31)]; }
    __builtin_amdgcn_wave_barrier(); asm volatile("s_waitcnt lgkmcnt(0)" ::: "memory");
    const int c = lane & 7;
#pragma unroll
    for (int j = 0; j < 4; ++j) { const int n = (lane >> 3) + 8 * j; const float* s = scr + (8 * c) * 33 + n;
        u32x4 o; o.x = pk2(s[0 * 33], s[1 * 33]); o.y = pk2(s[2 * 33], s[3 * 33]); o.z = pk2(s[4 * 33], s[5 * 33]); o.w = pk2(s[6 * 33], s[7 * 33]);
        *(u32x4*)(WT + (size_t)(drow0 + n) * K + k0 + 8 * c) = o; }
    __builtin_amdgcn_wave_barrier(); asm volatile("s_waitcnt lgkmcnt(0)" ::: "memory");
}

DI void sincos_acc(float ang, float& c, float& s) {
    const double TWO_PI = 6.283185307179586476925286766559, INV_2PI = 0.15915494309189533576888376337251;
    double a = (double)ang; double n = rint(a * INV_2PI); double r = fma(-n, TWO_PI, a);
    double r2 = r * r;
    double sn = -1.0 / 51090942171709440000.0;
    sn = fma(sn, r2, 1.0 / 121645100408832000.0); sn = fma(sn, r2, -1.0 / 355687428096000.0); sn = fma(sn, r2, 1.0 / 1307674368000.0); sn = fma(sn, r2, -1.0 / 6227020800.0);
    sn = fma(sn, r2, 1.0 / 39916800.0); sn = fma(sn, r2, -1.0 / 362880.0); sn = fma(sn, r2, 1.0 / 5040.0); sn = fma(sn, r2, -1.0 / 120.0); sn = fma(sn, r2, 1.0 / 6.0);
    sn = fma(sn, r2, -1.0); sn = -sn * r;
    double cs = 1.0 / 2432902008176640000.0;
    cs = fma(cs, r2, -1.0 / 6402373705728000.0); cs = fma(cs, r2, 1.0 / 20922789888000.0); cs = fma(cs, r2, -1.0 / 87178291200.0); cs = fma(cs, r2, 1.0 / 479001600.0);
    cs = fma(cs, r2, -1.0 / 3628800.0); cs = fma(cs, r2, 1.0 / 40320.0); cs = fma(cs, r2, -1.0 / 720.0); cs = fma(cs, r2, 1.0 / 24.0); cs = fma(cs, r2, -0.5); cs = fma(cs, r2, 1.0);
    c = (float)cs; s = (float)sn;
}

DI void p0_prologue(const Args& A, unsigned char* lds, int tid, int lane, int wave) {
    unsigned char* ws = A.ws;
    float* scr = (float*)(lds + wave * 16384);
    const int gw = blockIdx.x * 8 + wave, NGW = gridDim.x * 8;
    constexpr int I_ADA = 2 * 16 * 288, I_IN = 4 * 16 * 176, I_OUT = 4 * 44 * 32, I_MIN = 2 * 16 * 80, I_MOUT = 2 * 16 * 32;
    constexpr int NITEMS = I_ADA + I_IN + I_OUT + I_MIN + I_MOUT;
    for (int it0 = gw; it0 < NITEMS; it0 += NGW) {
        int it = it0; const float* W; bf16_t* WT; int K, N, r; bool swz = false;
        if (it < I_ADA) { const int l = it / 4608; r = it % 4608; K = 1024; N = 9216; W = A.in[8] + (size_t)l * K * N; WT = (bf16_t*)(ws + WS_WADA) + (size_t)l * N * K; }
        else if ((it -= I_ADA) < I_IN) { const int m = it / 2816; r = it % 2816; K = 1024; N = 5632; W = A.in[12] + (size_t)m * K * N; WT = (bf16_t*)(ws + WS_WIN) + (size_t)m * N * K; swz = true; }
        else if ((it -= I_IN) < I_OUT) { const int m = it / 1408; r = it % 1408; K = 2816; N = 1024; W = A.in[13] + (size_t)m * K * N; WT = (bf16_t*)(ws + WS_WOUT) + (size_t)m * N * K; }
        else if ((it -= I_OUT) < I_MIN) { const int l = it / 1280; r = it % 1280; K = 1024; N = 2560; W = A.in[14] + (size_t)l * K * N; WT = (bf16_t*)(ws + WS_WMIN) + (size_t)l * N * K; }
        else { it -= I_MIN; const int l = it / 512; r = it % 512; K = 1024; N = 1024; W = A.in[15] + (size_t)l * K * N; WT = (bf16_t*)(ws + WS_WMOUT) + (size_t)l * N * K; }
        const int nblk = N / 32, kb = r / nblk, nb = r % nblk, k0 = 64 * kb, n0 = 32 * nb;
        int drow0 = n0;
        if (swz) { const int j = n0 < DFF ? n0 : n0 - DFF; drow0 = (j >> 7) * 256 + (j & 127) + (n0 < DFF ? 0 : 128); }
        transpose_item(W, K, N, WT, k0, n0, drow0, scr, lane);
    }
    const int gt = blockIdx.x * NTHREADS + tid, NGT = gridDim.x * NTHREADS;
    bf16_t* amod = (bf16_t*)(ws + WS_AMOD);
    for (int e = gt; e < 256 * 1024; e += NGT) { const int r = e >> 10, d = e & 1023; float v = 0.f;
        if (r < NB) v = A.in[6][r * DM + d]; else if (r < NBT) v = A.in[7][(r - NB) * DM + d];
        amod[e] = (bf16_t)f2bf(v * sigmoidf_(v)); }
    float* rope = (float*)(ws + WS_ROPE);
    for (int e = gt; e < 2056 * 32; e += NGT) { const int idx = e >> 5, j = e & 31; const int pos = idx < 2048 ? idx : PAST + idx - 2048;
        const float inv = powf(10000.0f, -(float)j / 32.0f); const float ang = (float)pos * inv; float c, s; sincos_acc(ang, c, s);
        rope[2 * e] = c; rope[2 * e + 1] = s; }
}

DI void row_pass(const Args& A, bool has_post, int lp, int ip, float resw, bool has_pre, int ln, int inn, bool from_input, int lane, int wave) {
    unsigned char* ws = A.ws;
    const float* mod = (const float*)(ws + WS_MOD);
    const bf16_t* OUT = (const bf16_t*)(ws + WS_OUT); bf16_t* H = (bf16_t*)(ws + WS_H);
    float* X = A.out + O_X;
    const int gw = blockIdx.x * 8 + wave, NGW = gridDim.x * 8;
    const float* gpost = A.in[11] + ((size_t)lp * 3 + ip) * DM; const float* gpre = A.in[10] + ((size_t)ln * 3 + inn) * DM;
    for (int r = gw; r < MT; r += NGW) {
        const int br = mod_row(r);
        const float* xs = from_input ? (r < MP ? A.in[0] + (size_t)r * DM : A.in[1] + (size_t)(r - MP) * DM) : X + (size_t)r * DM;
        f32x4 x[4];
#pragma unroll
        for (int j = 0; j < 4; ++j) x[j] = *(const f32x4*)(xs + 256 * j + 4 * lane);
        if (has_post) {
            const float* gate = mod + ((size_t)lp * NBT + br) * NMOD + (ip * 3 + 2) * DM;
            f32x4 o[4]; float ss = 0.f;
#pragma unroll
            for (int j = 0; j < 4; ++j) { const u32x2 w = *(const u32x2*)(OUT + (size_t)r * DM + 256 * j + 4 * lane);
                o[j] = (f32x4){bflo(w.x), bfhi(w.x), bflo(w.y), bfhi(w.y)}; ss += (o[j].x * o[j].x + o[j].y * o[j].y) + (o[j].z * o[j].z + o[j].w * o[j].w); }
            const float rstd = rsqrtf(wave_sum(ss) * (1.0f / DM) + EPS) * resw;
#pragma unroll
            for (int j = 0; j < 4; ++j) { const f32x4 g = *(const f32x4*)(gate + 256 * j + 4 * lane); const f32x4 gp = *(const f32x4*)(gpost + 256 * j + 4 * lane);
                x[j] = x[j] + g * (o[j] * rstd * gp); }
        }
        if (has_post || from_input) {
#pragma unroll
            for (int j = 0; j < 4; ++j) *(f32x4*)(X + (size_t)r * DM + 256 * j + 4 * lane) = x[j];
        }
        if (has_pre) {
            const float* shift = mod + ((size_t)ln * NBT + br) * NMOD + (inn * 3 + 0) * DM; const float* scale = shift + DM;
            float ss = 0.f;
#pragma unroll
            for (int j = 0; j < 4; ++j) ss += (x[j].x * x[j].x + x[j].y * x[j].y) + (x[j].z * x[j].z + x[j].w * x[j].w);
            const float rstd = rsqrtf(wave_sum(ss) * (1.0f / DM) + EPS);
#pragma unroll
            for (int j = 0; j < 4; ++j) { const f32x4 sh = *(const f32x4*)(shift + 256 * j + 4 * lane), sc = *(const f32x4*)(scale + 256 * j + 4 * lane), gp = *(const f32x4*)(gpre + 256 * j + 4 * lane);
                const f32x4 h = (x[j] * rstd * gp) * (sc + 1.0f) + sh;
                u32x2 w; w.x = pk2(h.x, h.y); w.y = pk2(h.z, h.w); *(u32x2*)(H + (size_t)r * DM + 256 * j + 4 * lane) = w; }
        }
    }
}

template <class MaskF>
DI void attn_wave32(const bf16_t* Kl, const bf16_t* VTl, int VST, const bf16x8 (&qf)[4], float sink, MaskF valid, int r32, int hi, f32x16 (&o)[2]) {
    f32x16 s[5];
#pragma unroll
    for (int j = 0; j < 5; ++j) {
#pragma unroll
        for (int i = 0; i < 16; ++i) s[j][i] = 0.f;
#pragma unroll
        for (int ds = 0; ds < 4; ++ds) { const bf16x8 a = *(const bf16x8*)(Kl + (j * 32 + r32) * 72 + 16 * ds + 8 * hi); s[j] = MFMA32(a, qf[ds], s[j]); }
    }
    float m = -1e30f;
#pragma unroll
    for (int j = 0; j < 5; ++j)
#pragma unroll
        for (int i = 0; i < 16; ++i) { const int key = j * 32 + crow(i, hi); const float v = valid(key) ? s[j][i] : -1e30f; s[j][i] = v; m = fmaxf(m, v); }
    m = fmaxf(m, __shfl_xor(m, 32)); m = fmaxf(m, sink);
    float l = 0.f;
#pragma unroll
    for (int j = 0; j < 5; ++j)
#pragma unroll
        for (int i = 0; i < 16; ++i) { const float p = __expf(s[j][i] - m); s[j][i] = p; l += p; }
    l += __shfl_xor(l, 32);
    const float inv = 1.0f / (l + __expf(sink - m));
#pragma unroll
    for (int db = 0; db < 2; ++db)
#pragma unroll
        for (int i = 0; i < 16; ++i) o[db][i] = 0.f;
#pragma unroll
    for (int j = 0; j < 5; ++j)
#pragma unroll
        for (int st = 0; st < 2; ++st) {
            u32x4 pw; pw.x = pk2(s[j][8 * st + 0] * inv, s[j][8 * st + 1] * inv); pw.y = pk2(s[j][8 * st + 2] * inv, s[j][8 * st + 3] * inv);
            pw.z = pk2(s[j][8 * st + 4] * inv, s[j][8 * st + 5] * inv); pw.w = pk2(s[j][8 * st + 6] * inv, s[j][8 * st + 7] * inv);
            const bf16x8 pf = __builtin_bit_cast(bf16x8, pw);
#pragma unroll
            for (int db = 0; db < 2; ++db) { const bf16_t* vp = VTl + (32 * db + r32) * VST + j * 32 + 16 * st + 4 * hi;
                const s16x4 lo = *(const s16x4*)vp, hi4 = *(const s16x4*)(vp + 8);
                const bf16x8 vf = __builtin_shufflevector(lo, hi4, 0, 1, 2, 3, 4, 5, 6, 7);
                o[db] = MFMA32(vf, pf, o[db]); }
        }
}
DI void attn_store(const f32x16 (&o)[2], bf16_t* dst  , int hi) {
#pragma unroll
    for (int db = 0; db < 2; ++db)
#pragma unroll
        for (int g4 = 0; g4 < 4; ++g4) { u32x2 w; w.x = pk2(o[db][4 * g4], o[db][4 * g4 + 1]); w.y = pk2(o[db][4 * g4 + 2], o[db][4 * g4 + 3]);
            *(u32x2*)(dst + 32 * db + 8 * g4 + 4 * hi) = w; }
}
DI void load_q(const bf16_t* zq, const float* cs, int hi, bf16x8 (&qf)[4]) {
#pragma unroll
    for (int ds = 0; ds < 2; ++ds) { const int d1 = 16 * ds + 8 * hi; float x1[8], x2[8], y1[8], y2[8];
        unpack8(*(const u32x4*)(zq + d1), x1); unpack8(*(const u32x4*)(zq + d1 + 32), x2);
#pragma unroll
        for (int e = 0; e < 8; ++e) { const float c = cs[2 * (d1 + e)], s = cs[2 * (d1 + e) + 1]; y1[e] = (x1[e] * c - x2[e] * s) * 0.125f; y2[e] = (x2[e] * c + x1[e] * s) * 0.125f; }
        qf[ds] = __builtin_bit_cast(bf16x8, pack8(y1)); qf[ds + 2] = __builtin_bit_cast(bf16x8, pack8(y2)); }
}

DI void attn_prompt_unit(const Args& A, int l, int u, unsigned char* lds, int tid, int lane, int wave) {
    unsigned char* ws = A.ws;
    const bf16_t* Z = (const bf16_t*)(ws + WS_BIG); bf16_t* CAT = (bf16_t*)(ws + WS_H); const float* rope = (const float*)(ws + WS_ROPE);
    const int b = u >> 6, kvh = (u >> 5) & 1, qb = u & 31, q0 = qb * 64;
    bf16_t* Kl = (bf16_t*)lds; bf16_t* VTl = (bf16_t*)(lds + 27648); constexpr int VST = 200;
    float* nk = A.out + O_KP + ((size_t)(l * NB + b) * 128) * 128 + kvh * 64; float* nv = A.out + O_VP + ((size_t)(l * NB + b) * 128) * 128 + kvh * 64;
    for (int it = tid; it < 192 * 4; it += NTHREADS) { const int key = it >> 2, o = it & 3; const int pos = q0 - 128 + key;
        float y1[8], y2[8];
        if (pos >= 0) { const bf16_t* zk = Z + (size_t)(b * SEQ + pos) * DIN + KA + kvh * 64 + 8 * o; float x1[8], x2[8];
            unpack8(*(const u32x4*)zk, x1); unpack8(*(const u32x4*)(zk + 32), x2); const float* cs = rope + (size_t)pos * 64 + 16 * o;
#pragma unroll
            for (int e = 0; e < 8; ++e) { const float c = cs[2 * e], s = cs[2 * e + 1]; y1[e] = x1[e] * c - x2[e] * s; y2[e] = x2[e] * c + x1[e] * s; }
            if (qb == 31 && key >= 64) { float* d = nk + (size_t)(key - 64) * 128 + 8 * o;
                *(f32x4*)d = (f32x4){y1[0], y1[1], y1[2], y1[3]}; *(f32x4*)(d + 4) = (f32x4){y1[4], y1[5], y1[6], y1[7]};
                *(f32x4*)(d + 32) = (f32x4){y2[0], y2[1], y2[2], y2[3]}; *(f32x4*)(d + 36) = (f32x4){y2[4], y2[5], y2[6], y2[7]}; }
        } else {
#pragma unroll
            for (int e = 0; e < 8; ++e) { y1[e] = 0.f; y2[e] = 0.f; } }
        *(u32x4*)(Kl + key * 72 + 8 * o) = pack8(y1); *(u32x4*)(Kl + key * 72 + 32 + 8 * o) = pack8(y2); }
    for (int it = tid; it < 192 * 8; it += NTHREADS) { const int key = it >> 3, o = it & 7; const int pos = q0 - 128 + key;
        u32x4 w = (u32x4){0u, 0u, 0u, 0u};
        if (pos >= 0) { w = *(const u32x4*)(Z + (size_t)(b * SEQ + pos) * DIN + VA + kvh * 64 + 8 * o);
            if (qb == 31 && key >= 64) { float x[8]; unpack8(w, x); float* d = nv + (size_t)(key - 64) * 128 + 8 * o;
                *(f32x4*)d = (f32x4){x[0], x[1], x[2], x[3]}; *(f32x4*)(d + 4) = (f32x4){x[4], x[5], x[6], x[7]}; } }
        bf16_t* vt = VTl + (8 * o) * VST + key;
        vt[0] = (bf16_t)(w.x & 0xffffu); vt[VST] = (bf16_t)(w.x >> 16); vt[2 * VST] = (bf16_t)(w.y & 0xffffu); vt[3 * VST] = (bf16_t)(w.y >> 16);
        vt[4 * VST] = (bf16_t)(w.z & 0xffffu); vt[5 * VST] = (bf16_t)(w.z >> 16); vt[6 * VST] = (bf16_t)(w.w & 0xffffu); vt[7 * VST] = (bf16_t)(w.w >> 16); }
    __syncthreads();
    {
        const int g = wave >> 1, half = wave & 1, r32 = lane & 31, hi = lane >> 5, head = kvh * 4 + g;
        const int qpos = q0 + 32 * half + r32; const size_t row = (size_t)b * SEQ + qpos;
        bf16x8 qf[4]; load_q(Z + row * DIN + QA + head * 64, rope + (size_t)qpos * 64, hi, qf);
        const float sink = A.in[16][l * 8 + head];
        const int kbase = q0 - 128 + 32 * half;
        f32x16 o[2];
        attn_wave32(Kl + half * 32 * 72, VTl + half * 32, VST, qf, sink,
                    [&](int key) { const int diff = 128 + r32 - key; return diff >= 0 && diff < 128 && (kbase + key) >= 0; }, r32, hi, o);
        attn_store(o, CAT + row * DM + head * 64, hi);
    }
    __syncthreads();
}

DI void attn_sample_unit(const Args& A, int l, int b, unsigned char* lds, int tid, int lane, int wave) {
    unsigned char* ws = A.ws;
    const bf16_t* Z = (const bf16_t*)(ws + WS_BIG); bf16_t* CAT = (bf16_t*)(ws + WS_H); const float* rope = (const float*)(ws + WS_ROPE);
    constexpr int VST = 168, KV_BYTES = 23040 + 21504;
    const float* ck = A.in[2] + ((size_t)(l * DB + b) * 128) * 128; const float* cv = A.in[3] + ((size_t)(l * DB + b) * 128) * 128;
    float* nk = A.out + O_KS + ((size_t)(l * DB + b) * 128) * 128; float* nv = A.out + O_VS + ((size_t)(l * DB + b) * 128) * 128;
    for (int it = tid; it < 2 * 160 * 4; it += NTHREADS) { const int kvh = it / 640, rr = it % 640, key = rr >> 2, o = rr & 3;
        bf16_t* Kl = (bf16_t*)(lds + kvh * KV_BYTES);
        float y1[8], y2[8];
        if (key < 128) { const float* s = ck + (size_t)key * 128 + kvh * 64 + 8 * o;
#pragma unroll
            for (int e = 0; e < 8; ++e) { y1[e] = s[e]; y2[e] = s[32 + e]; }
        } else if (key < 136) { const int i = key - 128; const bf16_t* zk = Z + (size_t)(MP + b * DS + i) * DIN + KA + kvh * 64 + 8 * o; float x1[8], x2[8];
            unpack8(*(const u32x4*)zk, x1); unpack8(*(const u32x4*)(zk + 32), x2); const float* cs = rope + (size_t)(2048 + i) * 64 + 16 * o;
#pragma unroll
            for (int e = 0; e < 8; ++e) { const float c = cs[2 * e], s = cs[2 * e + 1]; y1[e] = x1[e] * c - x2[e] * s; y2[e] = x2[e] * c + x1[e] * s; }
        } else {
#pragma unroll
            for (int e = 0; e < 8; ++e) { y1[e] = 0.f; y2[e] = 0.f; } }
        if (key >= 8 && key < 136) { float* d = nk + (size_t)(key - 8) * 128 + kvh * 64 + 8 * o;
#pragma unroll
            for (int e = 0; e < 8; ++e) { d[e] = y1[e]; d[32 + e] = y2[e]; } }
        *(u32x4*)(Kl + key * 72 + 8 * o) = pack8(y1); *(u32x4*)(Kl + key * 72 + 32 + 8 * o) = pack8(y2); }
    for (int it = tid; it < 2 * 160 * 8; it += NTHREADS) { const int kvh = it / 1280, rr = it % 1280, key = rr >> 3, o = rr & 7;
        bf16_t* VTl = (bf16_t*)(lds + kvh * KV_BYTES + 23040);
        float x[8];
        if (key < 128) { const float* s = cv + (size_t)key * 128 + kvh * 64 + 8 * o;
#pragma unroll
            for (int e = 0; e < 8; ++e) x[e] = s[e];
        } else if (key < 136) { unpack8(*(const u32x4*)(Z + (size_t)(MP + b * DS + key - 128) * DIN + VA + kvh * 64 + 8 * o), x);
        } else {
#pragma unroll
            for (int e = 0; e < 8; ++e) x[e] = 0.f; }
        if (key >= 8 && key < 136) { float* d = nv + (size_t)(key - 8) * 128 + kvh * 64 + 8 * o;
#pragma unroll
            for (int e = 0; e < 8; ++e) d[e] = x[e]; }
#pragma unroll
        for (int e = 0; e < 8; ++e) VTl[(8 * o + e) * VST + key] = (bf16_t)f2bf(x[e]); }
    __syncthreads();
    if (wave < 2) {
        const int kvh = wave, r32 = lane & 31, hi = lane >> 5, g = r32 >> 3, i = r32 & 7, head = kvh * 4 + g;
        const size_t row = (size_t)MP + b * DS + i;
        bf16x8 qf[4]; load_q(Z + row * DIN + QA + head * 64, rope + (size_t)(2048 + i) * 64, hi, qf);
        const float sink = A.in[16][l * 8 + head];
        f32x16 o[2];
        attn_wave32((const bf16_t*)(lds + kvh * KV_BYTES), (const bf16_t*)(lds + kvh * KV_BYTES + 23040), VST, qf, sink,
                    [&](int key) { return key < 128 ? (key > i) : (key < 136 && (key - 128) <= i); }, r32, hi, o);
        attn_store(o, CAT + row * DM + head * 64, hi);
    }
    __syncthreads();
}

DI float lb_val(const float* lbraw, int l, int idx) { if (l == 0) return 0.f; const float a = lbraw[idx], b = lbraw[256 + idx]; return 1.0f / (1.0f + __expf(a - b)); }

DI void hg_gates_cumsum(const bf16_t* Z, size_t row0, int h, const float* lbraw, int l, float* lf, float* kk, float* tot, int tid) {
    { const int t = tid >> 3, k0 = (tid & 7) * 8; float x[8];
      unpack8(*(const u32x4*)(Z + (row0 + t) * DIN + FH + h * 64 + k0), x);
#pragma unroll
      for (int e = 0; e < 8; ++e) { const float lbv = lb_val(lbraw, l, h * 64 + k0 + e); const float xv = fminf(fmaxf(x[e], -60.f), 60.f);
          const float f = lbv + (1.0f - lbv) * sigmoidf_(xv); lf[t * 64 + k0 + e] = __logf(f); kk[t * 64 + k0 + e] = (1.0f - lbv) * sigmoidf_(-xv); } }
    __syncthreads();
    { const int k = tid & 63, seg = tid >> 6; float run = 0.f;
#pragma unroll
      for (int i = 0; i < 8; ++i) { run += lf[(8 * seg + i) * 64 + k]; lf[(8 * seg + i) * 64 + k] = run; }
      tot[seg * 64 + k] = run;
      __syncthreads();
      float off = 0.f;
      for (int s = 0; s < seg; ++s) off += tot[s * 64 + k];
#pragma unroll
      for (int i = 0; i < 8; ++i) lf[(8 * seg + i) * 64 + k] += off; }
    __syncthreads();
}

DI void hg_pass1_unit(const Args& A, int l, int u, unsigned char* lds, int tid, int lane, int wave) {
    unsigned char* ws = A.ws; const bf16_t* Z = (const bf16_t*)(ws + WS_BIG);
    const int b = u >> 7, h = (u >> 5) & 3, c = u & 31; const size_t row0 = (size_t)b * SEQ + c * 64;
    float* lf = (float*)lds; float* kk = (float*)(lds + 16384); float* tot = (float*)(lds + 32768); bf16_t* KT = (bf16_t*)(lds + 36864); bf16_t* VT = (bf16_t*)(lds + 36864 + 9216);
    hg_gates_cumsum(Z, row0, h, A.in[17], l, lf, kk, tot, tid);
    { const int t = tid >> 3, k0 = (tid & 7) * 8;
#pragma unroll
      for (int e = 0; e < 8; ++e) { const int k = k0 + e; KT[k * 72 + t] = (bf16_t)f2bf(kk[t * 64 + k] * __expf(lf[63 * 64 + k] - lf[t * 64 + k])); }
      const u32x4 w = *(const u32x4*)(Z + (row0 + t) * DIN + IH + h * 64 + k0); bf16_t* vt = VT + k0 * 72 + t;
      vt[0] = (bf16_t)(w.x & 0xffffu); vt[72] = (bf16_t)(w.x >> 16); vt[144] = (bf16_t)(w.y & 0xffffu); vt[216] = (bf16_t)(w.y >> 16);
      vt[288] = (bf16_t)(w.z & 0xffffu); vt[360] = (bf16_t)(w.z >> 16); vt[432] = (bf16_t)(w.w & 0xffffu); vt[504] = (bf16_t)(w.w >> 16); }
    if (tid < 64) ((float*)(ws + WS_HD))[(size_t)u * 64 + tid] = __expf(lf[63 * 64 + tid]);
    __syncthreads();
    { const int kt = wave >> 1, q4 = lane >> 4, c16 = lane & 15; float* U = (float*)(ws + WS_HU) + (size_t)u * 4096;
#pragma unroll
      for (int vv = 0; vv < 2; ++vv) { const int vt = 2 * (wave & 1) + vv; f32x4 acc = (f32x4){0.f, 0.f, 0.f, 0.f};
#pragma unroll
          for (int ks = 0; ks < 2; ++ks) { const bf16x8 a = *(const bf16x8*)(KT + (16 * kt + c16) * 72 + 32 * ks + 8 * q4); const bf16x8 bb = *(const bf16x8*)(VT + (16 * vt + c16) * 72 + 32 * ks + 8 * q4);
              acc = MFMA16(a, bb, acc); }
#pragma unroll
          for (int e = 0; e < 4; ++e) U[(16 * kt + 4 * q4 + e) * 64 + 16 * vt + c16] = acc[e]; } }
    __syncthreads();
}

DI void hg_scan_unit(const Args& A, int l, int u, int tid) {
    unsigned char* ws = A.ws; const int b = u >> 2, h = u & 3;
    float* U = (float*)(ws + WS_HU) + ((size_t)(b * 4 + h) * 32) * 4096; const float* D = (const float*)(ws + WS_HD) + ((size_t)(b * 4 + h) * 32) * 64;
    const int k = tid >> 3, v0 = (tid & 7) * 8;
    f32x4 s0 = (f32x4){0.f, 0.f, 0.f, 0.f}, s1 = s0;
    for (int c = 0; c < 32; ++c) { float* p = U + (size_t)c * 4096 + k * 64 + v0; const float d = D[c * 64 + k];
        const f32x4 u0 = *(const f32x4*)p, u1 = *(const f32x4*)(p + 4);
        *(f32x4*)p = s0; *(f32x4*)(p + 4) = s1;
        s0 = s0 * d + u0; s1 = s1 * d + u1; }
    float* so = A.out + O_SP + ((size_t)((l * NB + b) * 4 + h)) * 4096 + k * 64 + v0;
    *(f32x4*)so = s0; *(f32x4*)(so + 4) = s1;
}

DI void hg_pass3_unit(const Args& A, int l, int u, unsigned char* lds, int tid, int lane, int wave) {
    unsigned char* ws = A.ws; const bf16_t* Z = (const bf16_t*)(ws + WS_BIG); bf16_t* CAT = (bf16_t*)(ws + WS_H);
    const int b = u >> 7, h = (u >> 5) & 3, c = u & 31; const size_t row0 = (size_t)b * SEQ + c * 64;
    float* bb = (float*)lds; float* kk = (float*)(lds + 16384); float* qq = (float*)(lds + 32768); float* tot = (float*)(lds + 49152);
    bf16_t* VT = (bf16_t*)(lds + 53248); bf16_t* ST = (bf16_t*)(lds + 53248 + 9216); float* ssum = (float*)(lds + 53248 + 18432);
    { const int t = tid >> 3, k0 = (tid & 7) * 8; float x[8];
      unpack8(*(const u32x4*)(Z + (row0 + t) * DIN + QH + h * 64 + k0), x);
#pragma unroll
      for (int e = 0; e < 8; ++e) qq[t * 64 + k0 + e] = x[e];
      const u32x4 w = *(const u32x4*)(Z + (row0 + t) * DIN + IH + h * 64 + k0); bf16_t* vt = VT + k0 * 72 + t;
      vt[0] = (bf16_t)(w.x & 0xffffu); vt[72] = (bf16_t)(w.x >> 16); vt[144] = (bf16_t)(w.y & 0xffffu); vt[216] = (bf16_t)(w.y >> 16);
      vt[288] = (bf16_t)(w.z & 0xffffu); vt[360] = (bf16_t)(w.z >> 16); vt[432] = (bf16_t)(w.w & 0xffffu); vt[504] = (bf16_t)(w.w >> 16);
      const float* sp = (const float*)(ws + WS_HU) + (size_t)u * 4096 + t * 64 + k0; const f32x4 a0 = *(const f32x4*)sp, a1 = *(const f32x4*)(sp + 4);
      bf16_t* st = ST + k0 * 72 + t;
      st[0] = (bf16_t)f2bf(a0.x); st[72] = (bf16_t)f2bf(a0.y); st[144] = (bf16_t)f2bf(a0.z); st[216] = (bf16_t)f2bf(a0.w);
      st[288] = (bf16_t)f2bf(a1.x); st[360] = (bf16_t)f2bf(a1.y); st[432] = (bf16_t)f2bf(a1.z); st[504] = (bf16_t)f2bf(a1.w); }
    hg_gates_cumsum(Z, row0, h, A.in[17], l, bb, kk, tot, tid);
    const int ti = wave & 3, vh = wave >> 2, q4 = lane >> 4, c16 = lane & 15; const int t = 16 * ti + c16;
    float beta[16];
#pragma unroll
    for (int ks = 0; ks < 2; ++ks)
#pragma unroll
        for (int e = 0; e < 8; ++e) { const int k = 32 * ks + 8 * q4 + e; beta[ks * 8 + e] = ti > 0 ? bb[(16 * ti - 1) * 64 + k] : 0.f; }
    bf16x8 qi[2], qo[2];
#pragma unroll
    for (int ks = 0; ks < 2; ++ks) { float a[8], o8[8];
#pragma unroll
        for (int e = 0; e < 8; ++e) { const int k = 32 * ks + 8 * q4 + e; const float bt = bb[t * 64 + k], qv = qq[t * 64 + k]; a[e] = qv * __expf(bt - beta[ks * 8 + e]); o8[e] = qv * __expf(bt); }
        qi[ks] = __builtin_bit_cast(bf16x8, pack8(a)); qo[ks] = __builtin_bit_cast(bf16x8, pack8(o8)); }
    f32x4 pt[4];
#pragma unroll
    for (int j = 0; j < 4; ++j) { pt[j] = (f32x4){0.f, 0.f, 0.f, 0.f};
        if (j <= ti) { const int s = 16 * j + c16;
#pragma unroll
            for (int ks = 0; ks < 2; ++ks) { float a[8];
#pragma unroll
                for (int e = 0; e < 8; ++e) { const int k = 32 * ks + 8 * q4 + e; a[e] = kk[s * 64 + k] * __expf(beta[ks * 8 + e] - bb[s * 64 + k]); }
                pt[j] = MFMA16(__builtin_bit_cast(bf16x8, pack8(a)), qi[ks], pt[j]); }
            if (j == ti) {
#pragma unroll
                for (int e = 0; e < 4; ++e) if (4 * q4 + e > c16) pt[j][e] = 0.f; } } }
    f32x4 o[2]; float ss = 0.f;
#pragma unroll
    for (int vv = 0; vv < 2; ++vv) { const int vt = 2 * vh + vv; const int v = 16 * vt + c16; f32x4 acc = (f32x4){0.f, 0.f, 0.f, 0.f};
#pragma unroll
        for (int p = 0; p < 2; ++p) if (2 * p <= ti) {
            u32x4 pw; pw.x = pk2(pt[2 * p][0], pt[2 * p][1]); pw.y = pk2(pt[2 * p][2], pt[2 * p][3]); pw.z = pk2(pt[2 * p + 1][0], pt[2 * p + 1][1]); pw.w = pk2(pt[2 * p + 1][2], pt[2 * p + 1][3]);
            const s16x4 lo = *(const s16x4*)(VT + v * 72 + 32 * p + 4 * q4), hi4 = *(const s16x4*)(VT + v * 72 + 32 * p + 16 + 4 * q4);
            acc = MFMA16(__builtin_shufflevector(lo, hi4, 0, 1, 2, 3, 4, 5, 6, 7), __builtin_bit_cast(bf16x8, pw), acc); }
#pragma unroll
        for (int ks = 0; ks < 2; ++ks) { const bf16x8 a = *(const bf16x8*)(ST + v * 72 + 32 * ks + 8 * q4); acc = MFMA16(a, qo[ks], acc); }
        o[vv] = acc; ss += (acc[0] * acc[0] + acc[1] * acc[1]) + (acc[2] * acc[2] + acc[3] * acc[3]); }
    ss += __shfl_xor(ss, 16); ss += __shfl_xor(ss, 32);
    if (q4 == 0) ssum[vh * 64 + t] = ss;
    __syncthreads();
    { const float rstd = rsqrtf((ssum[t] + ssum[64 + t]) * (1.0f / 64.0f) + EPS); const float* gn = A.in[18] + l * 64;
#pragma unroll
      for (int vv = 0; vv < 2; ++vv) { const int v0 = 16 * (2 * vh + vv) + 4 * q4; const u32x2 gw = *(const u32x2*)(Z + (row0 + t) * DIN + GH + h * 64 + v0);
          const float g0 = bflo(gw.x), g1 = bfhi(gw.x), g2 = bflo(gw.y), g3 = bfhi(gw.y);
          const float r0 = o[vv][0] * rstd * gn[v0] * (g0 * sigmoidf_(g0)), r1 = o[vv][1] * rstd * gn[v0 + 1] * (g1 * sigmoidf_(g1));
          const float r2 = o[vv][2] * rstd * gn[v0 + 2] * (g2 * sigmoidf_(g2)), r3 = o[vv][3] * rstd * gn[v0 + 3] * (g3 * sigmoidf_(g3));
          u32x2 w; w.x = pk2(r0, r1); w.y = pk2(r2, r3); *(u32x2*)(CAT + (row0 + t) * DM + 512 + h * 64 + v0) = w; } }
    __syncthreads();
}

DI void hg_sample_unit(const Args& A, int l, int u, unsigned char* lds, int tid, int lane, int wave) {
    unsigned char* ws = A.ws; const bf16_t* Z = (const bf16_t*)(ws + WS_BIG); bf16_t* CAT = (bf16_t*)(ws + WS_H);
    const int b = u >> 2, h = u & 3; const size_t row0 = (size_t)MP + b * DS;
    float* fs = (float*)lds; float* ks_ = fs + 512; float* qs = fs + 1024; float* vs = fs + 1536; float* red = fs + 2048;
    { const int t = tid >> 6, k = tid & 63; const bf16_t* zr = Z + (row0 + t) * DIN + h * 64 + k;
      const float lbv = lb_val(A.in[17], l, h * 64 + k); const float xv = fminf(fmaxf(bf2f(zr[FH]), -60.f), 60.f);
      fs[tid] = lbv + (1.0f - lbv) * sigmoidf_(xv); ks_[tid] = (1.0f - lbv) * sigmoidf_(-xv); qs[tid] = bf2f(zr[QH]); vs[tid] = bf2f(zr[IH]); }
    __syncthreads();
    const int v = tid & 63, ksl = tid >> 6;
    const float* s0 = A.in[4] + ((size_t)((l * DB + b) * 4 + h)) * 4096;
    float S[8];
#pragma unroll
    for (int j = 0; j < 8; ++j) S[j] = s0[(8 * ksl + j) * 64 + v];
#pragma unroll
    for (int t = 0; t < 8; ++t) { const float vt = vs[t * 64 + v]; float po = 0.f;
#pragma unroll
        for (int j = 0; j < 8; ++j) { const int k = 8 * ksl + j; S[j] = fs[t * 64 + k] * S[j] + ks_[t * 64 + k] * vt; po += S[j] * qs[t * 64 + k]; }
        red[(t * 8 + ksl) * 64 + v] = po; }
    float* so = A.out + O_SS + ((size_t)((l * DB + b) * 4 + h)) * 4096;
#pragma unroll
    for (int j = 0; j < 8; ++j) so[(8 * ksl + j) * 64 + v] = S[j];
    __syncthreads();
    { const int t = tid >> 6; float o = 0.f;
#pragma unroll
      for (int s = 0; s < 8; ++s) o += red[(t * 8 + s) * 64 + v];
      const float rstd = rsqrtf(wave_sum(o * o) * (1.0f / 64.0f) + EPS);
      const float g = bf2f(Z[(row0 + t) * DIN + GH + h * 64 + v]);
      CAT[(row0 + t) * DM + 512 + h * 64 + v] = (bf16_t)f2bf(o * rstd * A.in[18][l * 64 + v] * (g * sigmoidf_(g))); }
    __syncthreads();
}

DI void conv_unit(const Args& A, int l, int u, int tid) {
    unsigned char* ws = A.ws; const bf16_t* Z = (const bf16_t*)(ws + WS_BIG); bf16_t* CAT = (bf16_t*)(ws + WS_H);
    const int r = u * 16 + (tid >> 5), c0 = (tid & 31) * 8;
    int t, T, b; bool samp = r >= MP;
    if (!samp) { b = r >> 11; t = r & 2047; T = SEQ; } else { b = (r - MP) >> 3; t = (r - MP) & 7; T = DS; }
    float u0[8], u1[8], u2[8], bc[8], x[8], y[8];
    { const bf16_t* z = Z + (size_t)r * DIN; unpack8(*(const u32x4*)(z + CC + c0), x); unpack8(*(const u32x4*)(z + HC + c0), y); unpack8(*(const u32x4*)(z + BC + c0), bc);
#pragma unroll
      for (int e = 0; e < 8; ++e) u2[e] = x[e] * y[e]; }
    if (t >= 1) { const bf16_t* z = Z + (size_t)(r - 1) * DIN; unpack8(*(const u32x4*)(z + CC + c0), x); unpack8(*(const u32x4*)(z + HC + c0), y);
#pragma unroll
        for (int e = 0; e < 8; ++e) u1[e] = x[e] * y[e];
    } else {
#pragma unroll
        for (int e = 0; e < 8; ++e) u1[e] = samp ? A.in[5][((size_t)(l * DB + b) * 2 + 1) * 256 + c0 + e] : 0.f; }
    if (t >= 2) { const bf16_t* z = Z + (size_t)(r - 2) * DIN; unpack8(*(const u32x4*)(z + CC + c0), x); unpack8(*(const u32x4*)(z + HC + c0), y);
#pragma unroll
        for (int e = 0; e < 8; ++e) u0[e] = x[e] * y[e];
    } else {
#pragma unroll
        for (int e = 0; e < 8; ++e) u0[e] = samp ? A.in[5][((size_t)(l * DB + b) * 2 + t) * 256 + c0 + e] : 0.f; }
    const float* cw = A.in[19] + (size_t)l * 3 * 256 + c0; float o[8];
#pragma unroll
    for (int e = 0; e < 8; ++e) o[e] = bc[e] * (u0[e] * cw[e] + u1[e] * cw[256 + e] + u2[e] * cw[512 + e]);
    *(u32x4*)(CAT + (size_t)r * DM + 768 + c0) = pack8(o);
    if (t >= T - 2) { float* d = samp ? A.out + O_CS + ((size_t)(l * DB + b) * 2 + (t - (T - 2))) * 256 + c0 : A.out + O_CP + ((size_t)(l * NB + b) * 2 + (t - (T - 2))) * 256 + c0;
#pragma unroll
        for (int e = 0; e < 8; ++e) d[e] = u2[e]; }
}

#define XB_TMO      128
#define XB_XCNT(j)  (256  + 64 * (j))
#define XB_XSUB(j)  (1280 + 64 * (j))
#define XB_XGEN(j)  (2304 + 64 * (j))
#define XB_TOP      3328
#define XB_TOPGEN   3392
#define XCD_BAR_WORDS 3456
#define XB_SPIN_CAP (1u << 18)

__device__ __forceinline__ unsigned xb_ld(unsigned* p)              { return __hip_atomic_load(p, __ATOMIC_RELAXED, __HIP_MEMORY_SCOPE_AGENT); }
__device__ __forceinline__ unsigned xb_add(unsigned* p, unsigned v) { return __hip_atomic_fetch_add(p, v, __ATOMIC_RELAXED, __HIP_MEMORY_SCOPE_AGENT); }
__device__ __forceinline__ unsigned xb_xcc_id() { return (unsigned)__builtin_amdgcn_s_getreg((3 << 11) | 20) & 0xFu; }
#define XB_SPIN(cond, bar) do { unsigned _sp = 0; while (cond) { __builtin_amdgcn_s_sleep(1); \
    if ((++_sp & 255u) == 0u) { if (xb_ld(&(bar)[XB_TMO])) break; if (_sp > XB_SPIN_CAP) { atomicAdd(&(bar)[XB_TMO], 1u); break; } } } } while (0)

struct XcdBarrier {
    unsigned* bar; unsigned x;
    volatile LAS unsigned* st;
};

__device__ __forceinline__ XcdBarrier xcd_barrier_post(unsigned* bar, volatile LAS unsigned* st) {
    XcdBarrier b; b.bar = bar; b.x = xb_xcc_id(); b.st = st;
    if (threadIdx.x == 0) (void)xb_add(&bar[XB_XCNT(b.x)], 1u);
    return b;
}
__device__ __forceinline__ void xcd_barrier_complete(unsigned* bar, unsigned x, unsigned& nloc, unsigned& nx) {
    const unsigned G = gridDim.x * gridDim.y * gridDim.z;
    unsigned sum, cnt, mine, sp = 0u;
    for (;;) {
        sum = 0u; cnt = 0u; mine = 0u;
#pragma unroll
        for (unsigned j = 0; j < 16; ++j) { const unsigned c = xb_ld(&bar[XB_XCNT(j)]); sum += c; cnt += (c > 0u) ? 1u : 0u; mine = (j == x) ? c : mine; }
        if (sum == G) break;
        __builtin_amdgcn_s_sleep(1);
        if ((++sp & 255u) == 0u) { if (xb_ld(&bar[XB_TMO])) break; if (sp > XB_SPIN_CAP) { atomicAdd(&bar[XB_TMO], 1u); break; } }
    }
    nloc = mine > 0u ? mine : 1u; nx = cnt > 0u ? cnt : 1u;
}

__device__ __forceinline__ void xcd_barrier(const XcdBarrier& b) {
    asm volatile("s_waitcnt vmcnt(0)" ::: "memory");
    __syncthreads();
    if (threadIdx.x == 0) {
        unsigned* bar = b.bar;
        __builtin_amdgcn_s_waitcnt(0);
        unsigned nloc = b.st[0], nx = b.st[1];
        if (nloc == 0u) { xcd_barrier_complete(bar, b.x, nloc, nx); b.st[0] = nloc; b.st[1] = nx; }
        const unsigned old = xb_add(&bar[XB_XSUB(b.x)], 1u);
        const unsigned gen = old / nloc;
        if (old + 1u == (gen + 1u) * nloc) {
            __builtin_amdgcn_fence(__ATOMIC_RELEASE, "agent");
            asm volatile("s_waitcnt vmcnt(0)" ::: "memory");
            const unsigned og = xb_add(&bar[XB_TOP], 1u);
            const unsigned tg = og / nx;
            if (og + 1u == (tg + 1u) * nx) xb_add(&bar[XB_TOPGEN], 1u);
            else XB_SPIN(xb_ld(&bar[XB_TOPGEN]) == tg, bar);
            __builtin_amdgcn_fence(__ATOMIC_ACQUIRE, "agent");
            xb_add(&bar[XB_XGEN(b.x)], 1u);
            asm volatile("s_waitcnt vmcnt(0)" ::: "memory");
        } else {
            XB_SPIN(xb_ld(&bar[XB_XGEN(b.x)]) == gen, bar);
            __builtin_amdgcn_fence(__ATOMIC_ACQUIRE, "agent");
            asm volatile("s_waitcnt vmcnt(0)" ::: "memory");
        }
    }
    __syncthreads();
}

__global__ void __launch_bounds__(NTHREADS, 2) hymba_fwd(Args A_unused) {
    extern __shared__ __attribute__((aligned(16))) unsigned char lds[];
    cg::grid_group grid = cg::this_grid();
    LAS unsigned char* ldsl = (LAS unsigned char*)lds;
#define LOADARGS() const __attribute__((address_space(4))) Args* ap_ = (const __attribute__((address_space(4))) Args*)__builtin_amdgcn_kernarg_segment_ptr(); asm volatile("" : "+s"(ap_)); Args A; _Pragma("unroll") for (int i_ = 0; i_ < 20; ++i_) A.in[i_] = ap_->in[i_]; A.out = ap_->out; A.ws = ap_->ws; unsigned char* ws = A.ws; (void)ws; int tid = threadIdx.x; asm volatile("" : "+v"(tid)); const int lane = tid & 63, wave = __builtin_amdgcn_readfirstlane(tid >> 6); (void)lane; (void)wave
    for (int u_ = threadIdx.x; u_ < (LDS_BYTES - 131072) / 4; u_ += NTHREADS) ((LAS unsigned*)(ldsl + 131072))[u_] = 0u;
    __syncthreads();
    XcdBarrier bar;
    { const __attribute__((address_space(4))) Args* ap0_ = (const __attribute__((address_space(4))) Args*)__builtin_amdgcn_kernarg_segment_ptr();
      bar = xcd_barrier_post((unsigned*)(ap0_->ws + WS_CTL), (volatile LAS unsigned*)(ldsl + 131072 + 64)); }
#define GSYNC() xcd_barrier(bar)

#ifndef SKIP_P0
    { LOADARGS(); p0_prologue(A, lds, tid, lane, wave); }
#endif
    grid.sync();
    { LOADARGS(); pg8::Gemm g{(const pg8::bf16_t*)(ws + WS_AMOD), (const pg8::bf16_t*)(ws + WS_WADA), 256, 2 * NMOD, DM}; pg8::StaticOrder S; S.init(256, 2 * NMOD, gridDim.x, blockIdx.x);
      pg8::EpiModF32 E{(float*)(ws + WS_MOD), A.in[9], NBT, NMOD};

#ifndef SKIP_G1
      pg8::gemm_phase<pg8::EpiModF32, pg8::StaticOrder, true, true>(ldsl, g, S, E);
#endif
 }
    GSYNC();

#ifndef SKIP_R1
    { LOADARGS(); row_pass(A, false, 0, 0, 0.f, true, 0, 0, true, lane, wave); }
#endif

    GSYNC();
    for (int l = 0; l < NL; ++l) {
        for (int f = 0; f < 2; ++f) {
            if (f == 1) {
                { LOADARGS(); pg8::Gemm g{(const pg8::bf16_t*)(ws + WS_H), (const pg8::bf16_t*)(ws + WS_WMIN) + (size_t)l * DIN * DM, MT, DIN, DM}; pg8::StaticOrder S; S.init(MT, DIN, gridDim.x, blockIdx.x);
                  pg8::EpiBf16 E{(pg8::bf16_t*)(ws + WS_BIG), DIN};

#ifndef SKIP_G2
                  pg8::gemm_phase<pg8::EpiBf16, pg8::StaticOrder, true, true>(ldsl, g, S, E);
#endif
 }
                GSYNC();
                for (int u = blockIdx.x; u < 2048 + 2112 + 512; u += gridDim.x) { LOADARGS();
#ifndef SKIP_HP1
                    if (u < 2048) hg_pass1_unit(A, l, u, lds, tid, lane, wave);
#endif
#ifndef SKIP_CONV
                    if (u >= 2048 && u < 2048 + 2112) conv_unit(A, l, u - 2048, tid);
#endif
#ifndef SKIP_HS
                    if (u >= 2048 + 2112) hg_sample_unit(A, l, u - 2048 - 2112, lds, tid, lane, wave);
#endif
                }
                GSYNC();
                for (int u = blockIdx.x; u < 64 + 1024 + 128; u += gridDim.x) { LOADARGS();
#ifndef SKIP_SCAN
                    if (u < 64) hg_scan_unit(A, l, u, tid);
#endif
#ifndef SKIP_AP
                    if (u >= 64 && u < 64 + 1024) attn_prompt_unit(A, l, u - 64, lds, tid, lane, wave);
#endif
#ifndef SKIP_AS
                    if (u >= 64 + 1024) attn_sample_unit(A, l, u - 64 - 1024, lds, tid, lane, wave);
#endif
                }
                GSYNC();
#ifndef SKIP_HP3
                for (int u = blockIdx.x; u < 2048; u += gridDim.x) { LOADARGS(); hg_pass3_unit(A, l, u, lds, tid, lane, wave); }
#endif
                GSYNC();
                { LOADARGS(); pg8::Gemm g{(const pg8::bf16_t*)(ws + WS_H), (const pg8::bf16_t*)(ws + WS_WMOUT) + (size_t)l * DM * DM, MT, DM, DM}; pg8::StaticOrder S; S.init(MT, DM, gridDim.x, blockIdx.x);
                  pg8::EpiBf16 E{(pg8::bf16_t*)(ws + WS_OUT), DM};

#ifndef SKIP_G3
                  pg8::gemm_phase<pg8::EpiBf16, pg8::StaticOrder, true, true>(ldsl, g, S, E);
#endif
 }
                GSYNC();

#ifndef SKIP_R2
                { LOADARGS(); row_pass(A, true, l, 1, 1.0f, true, l, 2, false, lane, wave); }
#endif

                GSYNC();
            }
            { LOADARGS(); pg8::Gemm g{(const pg8::bf16_t*)(ws + WS_H), (const pg8::bf16_t*)(ws + WS_WIN) + (size_t)(l * 2 + f) * 2 * DFF * DM, MT, 2 * DFF, DM}; pg8::StaticOrder S; S.init(MT, 2 * DFF, gridDim.x, blockIdx.x);
              pg8::EpiSwiGLU E{(pg8::bf16_t*)(ws + WS_BIG), DFF};

#ifndef SKIP_G4
              pg8::gemm_phase<pg8::EpiSwiGLU, pg8::StaticOrder, true, true>(ldsl, g, S, E);
#endif
 }
            GSYNC();
            { LOADARGS(); pg8::Gemm g{(const pg8::bf16_t*)(ws + WS_BIG), (const pg8::bf16_t*)(ws + WS_WOUT) + (size_t)(l * 2 + f) * DM * DFF, MT, DM, DFF}; pg8::StaticOrder S; S.init(MT, DM, gridDim.x, blockIdx.x);
              pg8::EpiBf16 E{(pg8::bf16_t*)(ws + WS_OUT), DM};

#ifndef SKIP_G5
              pg8::gemm_phase<pg8::EpiBf16, pg8::StaticOrder, true, true>(ldsl, g, S, E);
#endif
 }
            GSYNC();

#ifndef SKIP_R3
            if (f == 0) { LOADARGS(); row_pass(A, true, l, 0, 0.5f, true, l, 1, false, lane, wave); }
#endif


#ifndef SKIP_R4
            if (f == 1) { LOADARGS(); row_pass(A, true, l, 2, 0.5f, l + 1 < NL, l + 1, 0, false, lane, wave); }
#endif

            GSYNC();
        }
    }
}

extern "C" void kernel_launch(void* const* d_in, const int* in_sizes, int n_in, void* d_out, int out_size, void* d_ws, size_t ws_size, hipStream_t stream) {
    static int grid = 0;
    if (grid == 0) {
        if (n_in != 20 || (size_t)out_size != O_END || ws_size < WS_END) { fprintf(stderr, "kernel_launch: unexpected sizes n_in %d out %d ws %zu\n", n_in, out_size, ws_size); grid = -1; return; }
        int dev = 0, cus = 0, per_cu = 0;
        hipGetDevice(&dev); hipDeviceGetAttribute(&cus, hipDeviceAttributeMultiprocessorCount, dev);
        if (hipFuncSetAttribute((const void*)hymba_fwd, hipFuncAttributeMaxDynamicSharedMemorySize, LDS_BYTES) != hipSuccess) { fprintf(stderr, "kernel_launch: hipFuncSetAttribute failed\n"); grid = -1; return; }
        if (hipOccupancyMaxActiveBlocksPerMultiprocessor(&per_cu, (const void*)hymba_fwd, NTHREADS, LDS_BYTES) != hipSuccess || per_cu < 1) { fprintf(stderr, "kernel_launch: occupancy query says %d\n", per_cu); (void)hipGetLastError(); }
        grid = cus;
    }
    if (grid < 0) return;
    if (hipMemsetAsync((char*)d_ws + WS_CTL, 0, CTL_BYTES, stream) != hipSuccess) { fprintf(stderr, "kernel_launch: memset failed\n"); return; }
    Args a{};
    for (int i = 0; i < 20; ++i) a.in[i] = (const float*)d_in[i];
    a.out = (float*)d_out; a.ws = (unsigned char*)d_ws;
    void* args[] = {&a};
    hipError_t e = hipLaunchCooperativeKernel((const void*)hymba_fwd, dim3(grid), dim3(NTHREADS), args, LDS_BYTES, stream);
    if (e != hipSuccess) fprintf(stderr, "cooperative launch failed: %s (grid %d)\n", hipGetErrorString(e), grid);
}
```

```cpp
#include <hip/hip_runtime.h>
#include <hip/hip_cooperative_groups.h>
#include <cstdio>
#include <cstdint>
namespace cg = cooperative_groups;
namespace pg8 {
#define PG8_LAS __attribute__((address_space(3)))
typedef unsigned short bf16_t;
typedef short bf16x8 __attribute__((ext_vector_type(8)));
typedef float f32x4 __attribute__((ext_vector_type(4)));
typedef unsigned u32x4 __attribute__((ext_vector_type(4)));
constexpr int BM = 256, BK = 64, HALF = 128, HTB = HALF * BK * 2  , STAGE_BYTES = 8 * HTB, NXCD = 8, WGM = 8;

__host__ __device__ __forceinline__ int lds_byte(int r, int c) { const int st = (r >> 4) * 2 + (c >> 5), rr = r & 15, cc = c & 31, ob = rr * 64 + cc * 2; return st * 1024 + (ob ^ (((ob >> 9) & 1) << 5)); }
__host__ __device__ __forceinline__ void stage_rc(int b, int& R, int& C) { const int st = b / 1024, sb = b % 1024, swz = sb ^ (((sb >> 9) & 1) << 5); R = (st >> 1) * 16 + swz / 64; C = (st & 1) * 32 + (swz % 64) / 2; }
__host__ __device__ __forceinline__ int perm32(int rho) { const int n = rho >> 4, i = rho & 15; return 8 * (i >> 2) + 4 * n + (i & 3); }

struct Unit { int pm, pn; };
struct Gemm { const bf16_t* A; const bf16_t* Bt; int M, N, K; };

struct StaticOrder {
    int nM, nN, nwg, G, c;
    __host__ __device__ void init(int M, int N, int G_, int c_) { nM = M / BM; nN = N / BM; nwg = nM * nN; G = G_; c = c_; }
    __host__ __device__ bool next(int i, Unit& u) const {
        const long L = (long)i * G + c; if (L >= nwg) return false;
        int wgid = (int)L; { const int q = nwg / NXCD, r = nwg % NXCD, xcd = wgid % NXCD, off = wgid / NXCD; wgid = (xcd < r ? xcd * (q + 1) : r * (q + 1) + (xcd - r) * q) + off; }
        const int nig = WGM * nN, gid = wgid / nig, fm = gid * WGM, gsz = (nM - fm) < WGM ? (nM - fm) : WGM;
        u.pm = fm + ((wgid % nig) % gsz); u.pn = (wgid % nig) / gsz; return true;
    }
    __device__ __forceinline__ void a_ready(const Unit&) const {}
    __device__ __forceinline__ void done(const Unit&) const {}
};

__device__ __forceinline__ unsigned cvt_pk_bf16(float lo, float hi) { unsigned r; asm volatile("v_cvt_pk_bf16_f32 %0, %1, %2" : "=v"(r) : "v"(lo), "v"(hi)); return r; }
typedef float f32x2 __attribute__((ext_vector_type(2)));
struct EpiBf16 {
    static constexpr bool PERM = true, AFTER_DRAIN = false;
    bf16_t* O; int ldc;
    __device__ __forceinline__ void operator()(const f32x4 (&acc)[2][2][4][2], const Unit& u, int wr, int wc, int fr, int fq) const {
        const int row0 = u.pm * BM + wr * 64 + fr; const int col0 = u.pn * BM + wc * 32 + 8 * fq;
#pragma unroll
        for (int ai = 0; ai < 2; ++ai)
#pragma unroll
            for (int m = 0; m < 4; ++m) { bf16_t* rowp = O + (size_t)(row0 + ai * HALF + m * 16) * ldc + col0;
#pragma unroll
                for (int bj = 0; bj < 2; ++bj) { const f32x4 v0 = acc[ai][bj][m][0], v1 = acc[ai][bj][m][1];
                    u32x4 w; w.x = cvt_pk_bf16(v0[0], v0[1]); w.y = cvt_pk_bf16(v0[2], v0[3]); w.z = cvt_pk_bf16(v1[0], v1[1]); w.w = cvt_pk_bf16(v1[2], v1[3]);
                    *(u32x4*)(rowp + bj * HALF) = w; } }
    }
};
struct EpiSwiGLU {
    static constexpr bool PERM = true, AFTER_DRAIN = false;
    bf16_t* O; int ldc;
    __device__ __forceinline__ void operator()(const f32x4 (&acc)[2][2][4][2], const Unit& u, int wr, int wc, int fr, int fq) const {
        const int row0 = u.pm * BM + wr * 64 + fr; const int col0 = u.pn * HALF + wc * 32 + 8 * fq;
#pragma unroll
        for (int ai = 0; ai < 2; ++ai)
#pragma unroll
            for (int m = 0; m < 4; ++m) { bf16_t* rowp = O + (size_t)(row0 + ai * HALF + m * 16) * ldc + col0;
                float r[8];
#pragma unroll
                for (int n = 0; n < 2; ++n)
#pragma unroll
                    for (int e = 0; e < 4; ++e) { const float g = acc[ai][0][m][n][e], up = acc[ai][1][m][n][e];
                        r[n * 4 + e] = g * __builtin_amdgcn_rcpf(1.0f + __expf(-g)) * up; }
                u32x4 w; w.x = cvt_pk_bf16(r[0], r[1]); w.y = cvt_pk_bf16(r[2], r[3]); w.z = cvt_pk_bf16(r[4], r[5]); w.w = cvt_pk_bf16(r[6], r[7]);
                *(u32x4*)rowp = w; }
    }
};
struct EpiModF32 {
    static constexpr bool PERM = false, AFTER_DRAIN = false;
    float* O; const float* bias; int nrows; int ncols_l;
    __device__ __forceinline__ void operator()(const f32x4 (&acc)[2][2][4][2], const Unit& u, int wr, int wc, int fr, int fq) const {
        const int colt = u.pn * BM + wc * 32 + 4 * fq;
#pragma unroll
        for (int ai = 0; ai < 2; ++ai)
#pragma unroll
            for (int m = 0; m < 4; ++m) { const int r = u.pm * BM + ai * HALF + wr * 64 + m * 16 + fr;
                if (r < nrows) {
#pragma unroll
                    for (int bj = 0; bj < 2; ++bj)
#pragma unroll
                        for (int n = 0; n < 2; ++n) { const int c = colt + bj * HALF + n * 16; const int l = c / ncols_l, cc = c - l * ncols_l;
                            const f32x4 bv = *(const f32x4*)(bias + c);
                            *(f32x4*)(O + ((size_t)l * nrows + r) * ncols_l + cc) = acc[ai][bj][m][n] + bv; } } }
    }
};
template <class Epi, class Sched, bool ALIGN_EPI = false, bool SP2 = false>
__device__ __forceinline__ void gemm_phase(PG8_LAS unsigned char* lds, const Gemm g, const Sched& S, const Epi& E) {
    const int tid = threadIdx.x, wid = __builtin_amdgcn_readfirstlane(tid >> 6), lane = tid & 63, wr = wid >> 2, wc = wid & 3, fr = lane & 15, fq = lane >> 4;
    const int K = g.K, nt = K / BK;
    unsigned voffA[2], voffB[2];
#pragma unroll
    for (int i = 0; i < 2; ++i) { int R, C; stage_rc(tid * 16 + i * 8192, R, C); const int Rb = Epi::PERM ? ((R & ~31) + perm32(R & 31)) : R;
        voffA[i] = (unsigned)(R * K + C) * 2u; voffB[i] = (unsigned)(Rb * K + C) * 2u; }
    const size_t kstep = (size_t)(BK * 2);
    const size_t hstep = (size_t)HALF * K * 2;
    const size_t tstep = 2 * hstep;
    const unsigned ldsw = (unsigned)wid * 1024u;
    const int aoff = lds_byte(wr * 64 + fr, fq * 8), boff = lds_byte(wc * 32 + fr, fq * 8);
#define PG8_SA(b, h) (((b) * 2 + (h)) * HTB)
#define PG8_SB(b, h) ((4 + (b) * 2 + (h)) * HTB)
#define PG8_STAGE(bufoff, gbase, voff) do { _Pragma("unroll") for (int _i = 0; _i < 2; ++_i) \
        __builtin_amdgcn_global_load_lds((const unsigned*)((const char*)(gbase) + (voff)[_i]), (PG8_LAS unsigned*)(lds + (bufoff) + ldsw + _i * 8192), 16, 0, 0); } while (0)
#define PG8_LDA(dst, b, h) do { _Pragma("unroll") for (int m = 0; m < 4; ++m) _Pragma("unroll") for (int k = 0; k < 2; ++k) dst[m][k] = *(const PG8_LAS bf16x8*)(lds + PG8_SA(b, h) + aoff + m * 2048 + k * 1024); } while (0)
#define PG8_LDB(dst, b, h) do { _Pragma("unroll") for (int n = 0; n < 2; ++n) _Pragma("unroll") for (int k = 0; k < 2; ++k) dst[n][k] = *(const PG8_LAS bf16x8*)(lds + PG8_SB(b, h) + boff + n * 2048 + k * 1024); } while (0)
#define PG8_MMA(ai, bj, At, Bt) do { __builtin_amdgcn_s_setprio(1); _Pragma("unroll") for (int m = 0; m < 4; ++m) _Pragma("unroll") for (int n = 0; n < 2; ++n) _Pragma("unroll") for (int k = 0; k < 2; ++k) \
        acc[ai][bj][m][n] = __builtin_amdgcn_mfma_f32_16x16x32_bf16(Bt[n][k], At[m][k], acc[ai][bj][m][n], 0, 0, 0); __builtin_amdgcn_s_setprio(0); } while (0)
#define PG8_WAIT_V(n) asm volatile("s_waitcnt vmcnt(" #n ")" ::: "memory")
#define PG8_WAIT_L(n) asm volatile("s_waitcnt lgkmcnt(" #n ")" ::: "memory")
#define PG8_BAR __builtin_amdgcn_s_barrier()
#define PG8_SCHED __builtin_amdgcn_sched_barrier(0)
    Unit cur, nxt; int ui = 0;
    if (!S.next(0, cur)) return;
    f32x4 acc[2][2][4][2];
#pragma unroll
    for (int a = 0; a < 2; ++a)
#pragma unroll
        for (int b = 0; b < 2; ++b)
#pragma unroll
            for (int m = 0; m < 4; ++m)
#pragma unroll
                for (int n = 0; n < 2; ++n) acc[a][b][m][n] = (f32x4){0.f, 0.f, 0.f, 0.f};
    bf16x8 At[4][2], B0[2][2], B1[2][2];
    const char* cA = (const char*)g.A + (size_t)cur.pm * tstep; const char* cB = (const char*)g.Bt + (size_t)cur.pn * tstep;
    S.a_ready(cur);
    if constexpr (SP2) {
        PG8_STAGE(PG8_SB(0, 0), cB, voffB); PG8_STAGE(PG8_SB(0, 1), cB + hstep, voffB); PG8_STAGE(PG8_SA(0, 0), cA, voffA); PG8_STAGE(PG8_SA(0, 1), cA + hstep, voffA);
        if (wr == 1) PG8_BAR;
        PG8_WAIT_V(2); PG8_BAR;
        PG8_STAGE(PG8_SB(1, 0), cB + kstep, voffB); PG8_STAGE(PG8_SA(1, 0), cA + kstep, voffA); PG8_STAGE(PG8_SB(1, 1), cB + hstep + kstep, voffB);
        PG8_WAIT_V(6); PG8_BAR;
    } else {
        PG8_STAGE(PG8_SB(0, 0), cB, voffB); PG8_STAGE(PG8_SA(0, 0), cA, voffA); PG8_STAGE(PG8_SB(0, 1), cB + hstep, voffB); PG8_STAGE(PG8_SA(0, 1), cA + hstep, voffA);
        if (wr == 1) PG8_BAR;
        PG8_WAIT_V(4); PG8_BAR;
        PG8_STAGE(PG8_SB(1, 0), cB + kstep, voffB); PG8_STAGE(PG8_SA(1, 0), cA + kstep, voffA); PG8_STAGE(PG8_SB(1, 1), cB + hstep + kstep, voffB);
        PG8_WAIT_V(6); PG8_BAR;
    }
    for (;;) {
        const bool has_next = S.next(ui + 1, nxt);
        const char* nA = has_next ? (const char*)g.A + (size_t)nxt.pm * tstep : cA; const char* nB = has_next ? (const char*)g.Bt + (size_t)nxt.pn * tstep : cB;
        for (int t = 0; t < nt; t += 2) {
            const bool last = (t == nt - 2);
            const char* a1 = cA + (size_t)(t + 1) * kstep;
            const char* a2 = last ? nA : cA + (size_t)(t + 2) * kstep; const char* b2 = last ? nB : cB + (size_t)(t + 2) * kstep;
            const char* a3 = a2 + kstep; const char* b3 = b2 + kstep;
            if (last && has_next) S.a_ready(nxt);
            if constexpr (SP2) {
            PG8_LDB(B0, 0, 0); PG8_LDB(B1, 0, 1); PG8_SCHED; PG8_LDA(At, 0, 0); PG8_STAGE(PG8_SA(1, 1), a1 + hstep, voffA);
            PG8_WAIT_V(8); PG8_WAIT_L(0); PG8_BAR; PG8_MMA(0, 0, At, B0); PG8_MMA(0, 1, At, B1); PG8_BAR; PG8_SCHED;
            PG8_LDA(At, 0, 1); PG8_STAGE(PG8_SB(0, 0), b2, voffB); PG8_STAGE(PG8_SB(0, 1), b2 + hstep, voffB); PG8_STAGE(PG8_SA(0, 0), a2, voffA);
            PG8_WAIT_V(8); PG8_WAIT_L(0); PG8_BAR; PG8_MMA(1, 0, At, B0); PG8_MMA(1, 1, At, B1); PG8_BAR; PG8_SCHED;
            PG8_LDB(B0, 1, 0); PG8_LDB(B1, 1, 1); PG8_SCHED; PG8_LDA(At, 1, 0); PG8_STAGE(PG8_SA(0, 1), a2 + hstep, voffA);
            PG8_WAIT_V(8); PG8_WAIT_L(0); PG8_BAR; PG8_MMA(0, 0, At, B0); PG8_MMA(0, 1, At, B1); PG8_BAR; PG8_SCHED;
            PG8_LDA(At, 1, 1); PG8_STAGE(PG8_SB(1, 0), b3, voffB); PG8_STAGE(PG8_SB(1, 1), b3 + hstep, voffB); PG8_STAGE(PG8_SA(1, 0), a3, voffA);
            PG8_WAIT_V(8); PG8_WAIT_L(0); PG8_BAR; PG8_MMA(1, 0, At, B0); PG8_MMA(1, 1, At, B1); PG8_BAR; PG8_SCHED;
            } else {
            PG8_LDB(B0, 0, 0); PG8_SCHED; PG8_LDA(At, 0, 0); PG8_STAGE(PG8_SA(1, 1), a1 + hstep, voffA);
            PG8_WAIT_L(8); PG8_BAR; PG8_WAIT_L(0); PG8_MMA(0, 0, At, B0); PG8_BAR; PG8_SCHED;
            PG8_LDB(B1, 0, 1); PG8_STAGE(PG8_SB(0, 0), b2, voffB);
            PG8_BAR; PG8_WAIT_L(0); PG8_MMA(0, 1, At, B1); PG8_BAR;
            PG8_LDA(At, 0, 1); PG8_STAGE(PG8_SA(0, 0), a2, voffA);
            PG8_BAR; PG8_WAIT_L(0); PG8_MMA(1, 0, At, B0); PG8_BAR; PG8_SCHED;
            PG8_STAGE(PG8_SB(0, 1), b2 + hstep, voffB);
            PG8_WAIT_V(6); PG8_BAR; PG8_MMA(1, 1, At, B1); PG8_BAR;
            PG8_LDB(B0, 1, 0); PG8_SCHED; PG8_LDA(At, 1, 0); PG8_STAGE(PG8_SA(0, 1), a2 + hstep, voffA);
            PG8_WAIT_L(8); PG8_BAR; PG8_WAIT_L(0); PG8_MMA(0, 0, At, B0); PG8_BAR; PG8_SCHED;
            PG8_LDB(B1, 1, 1); PG8_STAGE(PG8_SB(1, 0), b3, voffB);
            PG8_BAR; PG8_WAIT_L(0); PG8_MMA(0, 1, At, B1); PG8_BAR;
            PG8_LDA(At, 1, 1); PG8_STAGE(PG8_SA(1, 0), a3, voffA);
            PG8_BAR; PG8_WAIT_L(0); PG8_MMA(1, 0, At, B0); PG8_BAR; PG8_SCHED;
            PG8_STAGE(PG8_SB(1, 1), b3 + hstep, voffB);
            PG8_WAIT_V(6); PG8_BAR; PG8_MMA(1, 1, At, B1); PG8_BAR;
            }
        }
        if constexpr (ALIGN_EPI) { if (wr == 0) PG8_BAR; }
        if constexpr (!Epi::AFTER_DRAIN) { E(acc, cur, wr, wc, fr, fq); S.done(cur); }
        if (!has_next) break;
#pragma unroll
        for (int a = 0; a < 2; ++a)
#pragma unroll
            for (int b = 0; b < 2; ++b)
#pragma unroll
                for (int m = 0; m < 4; ++m)
#pragma unroll
                    for (int n = 0; n < 2; ++n) acc[a][b][m][n] = (f32x4){0.f, 0.f, 0.f, 0.f};
        cur = nxt; cA = nA; cB = nB; ++ui;
        if constexpr (ALIGN_EPI) { if (wr == 1) PG8_BAR; }
    }
    PG8_WAIT_V(0);
    if constexpr (!ALIGN_EPI) { if (wr == 0) PG8_BAR; }
    PG8_BAR;
    if constexpr (Epi::AFTER_DRAIN) { E.fused(acc, cur, wr, wc, fr, fq, lds, wid, lane); S.done(cur); }
#undef PG8_SA
#undef PG8_SB
#undef PG8_STAGE
#undef PG8_LDA
#undef PG8_LDB
#undef PG8_MMA
#undef PG8_WAIT_V
#undef PG8_WAIT_L
#undef PG8_BAR
#undef PG8_SCHED
}
}
typedef unsigned short bf16_t;
typedef short bf16x8 __attribute__((ext_vector_type(8)));
typedef short s16x4 __attribute__((ext_vector_type(4)));
typedef float f32x4 __attribute__((ext_vector_type(4)));
typedef float f32x16 __attribute__((ext_vector_type(16)));
typedef unsigned u32x4 __attribute__((ext_vector_type(4)));
typedef unsigned u32x2 __attribute__((ext_vector_type(2)));
#define LAS __attribute__((address_space(3)))
#define DI __device__ __forceinline__

constexpr int DM = 1024, NB = 16, SEQ = 2048, NL = 2, DB = 128, DS = 8, PAST = 16384;
constexpr int MP = NB * SEQ, MS = DB * DS, MT = MP + MS;
constexpr int DIN = 2560, DFF = 2816, NBT = NB + DB, NMOD = 9 * DM;
constexpr int QA = 0, KA = 512, VA = 640, QH = 768, FH = 1024, IH = 1280, GH = 1536, BC = 1792, CC = 2048, HC = 2304;
constexpr float EPS = 1e-6f;
constexpr int NTHREADS = 512;
constexpr int LDS_BYTES = 147456;

constexpr size_t MiB = 1u << 20;
constexpr size_t WS_MOD = 0;
constexpr size_t WS_ROPE = 11 * MiB;
constexpr size_t WS_CTL = 11 * MiB + 768 * 1024, CTL_BYTES = 65536;
constexpr size_t WS_AMOD = 12 * MiB;
constexpr size_t WS_WADA = 13 * MiB;
constexpr size_t WS_WIN = 49 * MiB;
constexpr size_t WS_WOUT = 93 * MiB;
constexpr size_t WS_WMIN = 115 * MiB;
constexpr size_t WS_WMOUT = 125 * MiB;
constexpr size_t WS_H = 129 * MiB;
constexpr size_t WS_BIG = 195 * MiB;
constexpr size_t WS_OUT = 377 * MiB;
constexpr size_t WS_END = 443 * MiB;
constexpr size_t WS_HU = WS_OUT;
constexpr size_t WS_HD = WS_OUT + 32 * MiB;

constexpr size_t O_X = 0;
constexpr size_t O_KP = (size_t)MT * DM;
constexpr size_t O_VP = O_KP + 524288;
constexpr size_t O_SP = O_VP + 524288;
constexpr size_t O_CP = O_SP + 524288;
constexpr size_t O_KS = O_CP + 16384;
constexpr size_t O_VS = O_KS + 4194304;
constexpr size_t O_SS = O_VS + 4194304;
constexpr size_t O_CS = O_SS + 4194304;
constexpr size_t O_END = O_CS + 131072;

struct Args { const float* in[20]; float* out; unsigned char* ws; };

DI unsigned f2bf(float f) { unsigned u = __float_as_uint(f); return (u + 0x7fffu + ((u >> 16) & 1u)) >> 16; }
DI unsigned pk2(float lo, float hi) { return f2bf(lo) | (f2bf(hi) << 16); }
DI float bflo(unsigned w) { return __uint_as_float(w << 16); }
DI float bfhi(unsigned w) { return __uint_as_float(w & 0xffff0000u); }
DI float bf2f(bf16_t b) { return __uint_as_float((unsigned)b << 16); }
DI void unpack8(const u32x4 w, float (&x)[8]) { x[0] = bflo(w.x); x[1] = bfhi(w.x); x[2] = bflo(w.y); x[3] = bfhi(w.y); x[4] = bflo(w.z); x[5] = bfhi(w.z); x[6] = bflo(w.w); x[7] = bfhi(w.w); }
DI u32x4 pack8(const float (&x)[8]) { u32x4 w; w.x = pk2(x[0], x[1]); w.y = pk2(x[2], x[3]); w.z = pk2(x[4], x[5]); w.w = pk2(x[6], x[7]); return w; }
DI float sigmoidf_(float x) { return __builtin_amdgcn_rcpf(1.0f + __expf(-x)); }
DI float wave_sum(float v) {
#pragma unroll
    for (int o = 1; o < 64; o <<= 1) v += __shfl_xor(v, o);
    return v;
}
DI int crow(int r, int hi) { return (r & 3) + 8 * (r >> 2) + 4 * hi; }
#define MFMA32(a, b, c) __builtin_amdgcn_mfma_f32_32x32x16_bf16((a), (b), (c), 0, 0, 0)
#define MFMA16(a, b, c) __builtin_amdgcn_mfma_f32_16x16x32_bf16((a), (b), (c), 0, 0, 0)

DI int mod_row(int r) { return r < MP ? (r >> 11) : NB + ((r - MP) >> 3); }

DI void transpose_item(const float* W, int K, int N, bf16_t* WT, int k0, int n0, int drow0, float* scr, int lane) {
#pragma unroll 8
    for (int i = 0; i < 32; ++i) { const int kk = 2 * i + (lane >> 5); scr[kk * 33 + (lane & 31)] = W[(size_t)(k0 + kk) * N + n0 + (lane & 31)]; }
    __builtin_amdgcn_wave_barrier(); asm volatile("s_waitcnt lgkmcnt(0)" ::: "memory");
    const int c = lane & 7;
#pragma unroll
    for (int j = 0; j < 4; ++j) { const int n = (lane >> 3) + 8 * j; const float* s = scr + (8 * c) * 33 + n;
        u32x4 o; o.x = pk2(s[0 * 33], s[1 * 33]); o.y = pk2(s[2 * 33], s[3 * 33]); o.z = pk2(s[4 * 33], s[5 * 33]); o.w = pk2(s[6 * 33], s[7 * 33]);
        *(u32x4*)(WT + (size_t)(drow0 + n) * K + k0 + 8 * c) = o; }
    __builtin_amdgcn_wave_barrier(); asm volatile("s_waitcnt lgkmcnt(0)" ::: "memory");
}

DI void sincos_acc(float ang, float& c, float& s) {
    const double TWO_PI = 6.283185307179586476925286766559, INV_2PI = 0.15915494309189533576888376337251;
    double a = (double)ang; double n = rint(a * INV_2PI); double r = fma(-n, TWO_PI, a);
    double r2 = r * r;
    double sn = -1.0 / 51090942171709440000.0;
    sn = fma(sn, r2, 1.0 / 121645100408832000.0); sn = fma(sn, r2, -1.0 / 355687428096000.0); sn = fma(sn, r2, 1.0 / 1307674368000.0); sn = fma(sn, r2, -1.0 / 6227020800.0);
    sn = fma(sn, r2, 1.0 / 39916800.0); sn = fma(sn, r2, -1.0 / 362880.0); sn = fma(sn, r2, 1.0 / 5040.0); sn = fma(sn, r2, -1.0 / 120.0); sn = fma(sn, r2, 1.0 / 6.0);
    sn = fma(sn, r2, -1.0); sn = -sn * r;
    double cs = 1.0 / 2432902008176640000.0;
    cs = fma(cs, r2, -1.0 / 6402373705728000.0); cs = fma(cs, r2, 1.0 / 20922789888000.0); cs = fma(cs, r2, -1.0 / 87178291200.0); cs = fma(cs, r2, 1.0 / 479001600.0);
    cs = fma(cs, r2, -1.0 / 3628800.0); cs = fma(cs, r2, 1.0 / 40320.0); cs = fma(cs, r2, -1.0 / 720.0); cs = fma(cs, r2, 1.0 / 24.0); cs = fma(cs, r2, -0.5); cs = fma(cs, r2, 1.0);
    c = (float)cs; s = (float)sn;
}

DI void p0_prologue(const Args& A, unsigned char* lds, int tid, int lane, int wave) {
    unsigned char* ws = A.ws;
    float* scr = (float*)(lds + wave * 16384);
    const int gw = blockIdx.x * 8 + wave, NGW = gridDim.x * 8;
    constexpr int I_ADA = 2 * 16 * 288, I_IN = 4 * 16 * 176, I_OUT = 4 * 44 * 32, I_MIN = 2 * 16 * 80, I_MOUT = 2 * 16 * 32;
    constexpr int NITEMS = I_ADA + I_IN + I_OUT + I_MIN + I_MOUT;
    for (int it0 = gw; it0 < NITEMS; it0 += NGW) {
        int it = it0; const float* W; bf16_t* WT; int K, N, r; bool swz = false;
        if (it < I_ADA) { const int l = it / 4608; r = it % 4608; K = 1024; N = 9216; W = A.in[8] + (size_t)l * K * N; WT = (bf16_t*)(ws + WS_WADA) + (size_t)l * N * K; }
        else if ((it -= I_ADA) < I_IN) { const int m = it / 2816; r = it % 2816; K = 1024; N = 5632; W = A.in[12] + (size_t)m * K * N; WT = (bf16_t*)(ws + WS_WIN) + (size_t)m * N * K; swz = true; }
        else if ((it -= I_IN) < I_OUT) { const int m = it / 1408; r = it % 1408; K = 2816; N = 1024; W = A.in[13] + (size_t)m * K * N; WT = (bf16_t*)(ws + WS_WOUT) + (size_t)m * N * K; }
        else if ((it -= I_OUT) < I_MIN) { const int l = it / 1280; r = it % 1280; K = 1024; N = 2560; W = A.in[14] + (size_t)l * K * N; WT = (bf16_t*)(ws + WS_WMIN) + (size_t)l * N * K; }
        else { it -= I_MIN; const int l = it / 512; r = it % 512; K = 1024; N = 1024; W = A.in[15] + (size_t)l * K * N; WT = (bf16_t*)(ws + WS_WMOUT) + (size_t)l * N * K; }
        const int nblk = N / 32, kb = r / nblk, nb = r % nblk, k0 = 64 * kb, n0 = 32 * nb;
        int drow0 = n0;
        if (swz) { const int j = n0 < DFF ? n0 : n0 - DFF; drow0 = (j >> 7) * 256 + (j & 127) + (n0 < DFF ? 0 : 128); }
        transpose_item(W, K, N, WT, k0, n0, drow0, scr, lane);
    }
    const int gt = blockIdx.x * NTHREADS + tid, NGT = gridDim.x * NTHREADS;
    bf16_t* amod = (bf16_t*)(ws + WS_AMOD);
    for (int e = gt; e < 256 * 1024; e += NGT) { const int r = e >> 10, d = e & 1023; float v = 0.f;
        if (r < NB) v = A.in[6][r * DM + d]; else if (r < NBT) v = A.in[7][(r - NB) * DM + d];
        amod[e] = (bf16_t)f2bf(v * sigmoidf_(v)); }
    float* rope = (float*)(ws + WS_ROPE);
    for (int e = gt; e < 2056 * 32; e += NGT) { const int idx = e >> 5, j = e & 31; const int pos = idx < 2048 ? idx : PAST + idx - 2048;
        const float inv = powf(10000.0f, -(float)j / 32.0f); const float ang = (float)pos * inv; float c, s; sincos_acc(ang, c, s);
        rope[2 * e] = c; rope[2 * e + 1] = s; }
}

DI void row_pass(const Args& A, bool has_post, int lp, int ip, float resw, bool has_pre, int ln, int inn, bool from_input, int lane, int wave) {
    unsigned char* ws = A.ws;
    const float* mod = (const float*)(ws + WS_MOD);
    const bf16_t* OUT = (const bf16_t*)(ws + WS_OUT); bf16_t* H = (bf16_t*)(ws + WS_H);
    float* X = A.out + O_X;
    const int rpb = (MT + (int)gridDim.x - 1) / (int)gridDim.x; const int r0 = blockIdx.x * rpb; const int r1 = (r0 + rpb < MT) ? r0 + rpb : MT;
    const float* gpost = A.in[11] + ((size_t)lp * 3 + ip) * DM; const float* gpre = A.in[10] + ((size_t)ln * 3 + inn) * DM;
    f32x4 gp[4], gq[4], gate[4], sh[4], sc[4];
#pragma unroll
    for (int j = 0; j < 4; ++j) { gp[j] = has_post ? *(const f32x4*)(gpost + 256 * j + 4 * lane) : (f32x4){0.f, 0.f, 0.f, 0.f}; gq[j] = has_pre ? *(const f32x4*)(gpre + 256 * j + 4 * lane) : (f32x4){0.f, 0.f, 0.f, 0.f};
        gate[j] = (f32x4){0.f, 0.f, 0.f, 0.f}; sh[j] = gate[j]; sc[j] = gate[j]; }
    int br_c = -1;
    f32x4 xn[4]; u32x2 on[4];
#define RP_LOAD(rr) do { const float* xs_ = from_input ? ((rr) < MP ? A.in[0] + (size_t)(rr) * DM : A.in[1] + (size_t)((rr) - MP) * DM) : X + (size_t)(rr) * DM; \
        _Pragma("unroll") for (int j = 0; j < 4; ++j) { xn[j] = *(const f32x4*)(xs_ + 256 * j + 4 * lane); on[j] = has_post ? *(const u32x2*)(OUT + (size_t)(rr) * DM + 256 * j + 4 * lane) : (u32x2){0u, 0u}; } } while (0)
    int r = r0 + wave;
    if (r < r1) RP_LOAD(r);
    for (; r < r1; r += 8) {
        f32x4 x[4]; u32x2 ow[4];
#pragma unroll
        for (int j = 0; j < 4; ++j) { x[j] = xn[j]; ow[j] = on[j]; }
        if (r + 8 < r1) RP_LOAD(r + 8);
        const int br = mod_row(r);
        if (br != br_c) { br_c = br;
            const float* g_ = mod + ((size_t)lp * NBT + br) * NMOD + (ip * 3 + 2) * DM; const float* s_ = mod + ((size_t)ln * NBT + br) * NMOD + (inn * 3 + 0) * DM;
#pragma unroll
            for (int j = 0; j < 4; ++j) { if (has_post) gate[j] = *(const f32x4*)(g_ + 256 * j + 4 * lane);
                if (has_pre) { sh[j] = *(const f32x4*)(s_ + 256 * j + 4 * lane); sc[j] = *(const f32x4*)(s_ + DM + 256 * j + 4 * lane) + 1.0f; } } }
        if (has_post) {
            f32x4 o[4]; float ss = 0.f;
#pragma unroll
            for (int j = 0; j < 4; ++j) { o[j] = (f32x4){bflo(ow[j].x), bfhi(ow[j].x), bflo(ow[j].y), bfhi(ow[j].y)}; ss += (o[j].x * o[j].x + o[j].y * o[j].y) + (o[j].z * o[j].z + o[j].w * o[j].w); }
            const float rstd = rsqrtf(wave_sum(ss) * (1.0f / DM) + EPS) * resw;
#pragma unroll
            for (int j = 0; j < 4; ++j) x[j] = x[j] + gate[j] * (o[j] * rstd * gp[j]);
        }
        if (has_post || from_input) {
#pragma unroll
            for (int j = 0; j < 4; ++j) *(f32x4*)(X + (size_t)r * DM + 256 * j + 4 * lane) = x[j];
        }
        if (has_pre) {
            float ss = 0.f;
#pragma unroll
            for (int j = 0; j < 4; ++j) ss += (x[j].x * x[j].x + x[j].y * x[j].y) + (x[j].z * x[j].z + x[j].w * x[j].w);
            const float rstd = rsqrtf(wave_sum(ss) * (1.0f / DM) + EPS);
#pragma unroll
            for (int j = 0; j < 4; ++j) { const f32x4 h = (x[j] * rstd * gq[j]) * sc[j] + sh[j];
                u32x2 w; w.x = pk2(h.x, h.y); w.y = pk2(h.z, h.w); *(u32x2*)(H + (size_t)r * DM + 256 * j + 4 * lane) = w; }
        }
    }
#undef RP_LOAD
}

template <class MaskF>
DI void attn_wave32(const bf16_t* Kl, const bf16_t* VTl, int VST, const bf16x8 (&qf)[4], float sink, MaskF valid, int r32, int hi, f32x16 (&o)[2]) {
    f32x16 s[5];
#pragma unroll
    for (int j = 0; j < 5; ++j) {
#pragma unroll
        for (int i = 0; i < 16; ++i) s[j][i] = 0.f;
#pragma unroll
        for (int ds = 0; ds < 4; ++ds) { const bf16x8 a = *(const bf16x8*)(Kl + (j * 32 + r32) * 72 + 16 * ds + 8 * hi); s[j] = MFMA32(a, qf[ds], s[j]); }
    }
    float m = -1e30f;
#pragma unroll
    for (int j = 0; j < 5; ++j)
#pragma unroll
        for (int i = 0; i < 16; ++i) { const int key = j * 32 + crow(i, hi); const float v = valid(key) ? s[j][i] : -1e30f; s[j][i] = v; m = fmaxf(m, v); }
    m = fmaxf(m, __shfl_xor(m, 32)); m = fmaxf(m, sink);
    float l = 0.f;
#pragma unroll
    for (int j = 0; j < 5; ++j)
#pragma unroll
        for (int i = 0; i < 16; ++i) { const float p = __expf(s[j][i] - m); s[j][i] = p; l += p; }
    l += __shfl_xor(l, 32);
    const float inv = 1.0f / (l + __expf(sink - m));
#pragma unroll
    for (int db = 0; db < 2; ++db)
#pragma unroll
        for (int i = 0; i < 16; ++i) o[db][i] = 0.f;
#pragma unroll
    for (int j = 0; j < 5; ++j)
#pragma unroll
        for (int st = 0; st < 2; ++st) {
            u32x4 pw; pw.x = pk2(s[j][8 * st + 0] * inv, s[j][8 * st + 1] * inv); pw.y = pk2(s[j][8 * st + 2] * inv, s[j][8 * st + 3] * inv);
            pw.z = pk2(s[j][8 * st + 4] * inv, s[j][8 * st + 5] * inv); pw.w = pk2(s[j][8 * st + 6] * inv, s[j][8 * st + 7] * inv);
            const bf16x8 pf = __builtin_bit_cast(bf16x8, pw);
#pragma unroll
            for (int db = 0; db < 2; ++db) { const bf16_t* vp = VTl + (32 * db + r32) * VST + j * 32 + 16 * st + 4 * hi;
                const s16x4 lo = *(const s16x4*)vp, hi4 = *(const s16x4*)(vp + 8);
                const bf16x8 vf = __builtin_shufflevector(lo, hi4, 0, 1, 2, 3, 4, 5, 6, 7);
                o[db] = MFMA32(vf, pf, o[db]); }
        }
}
DI void attn_store(const f32x16 (&o)[2], bf16_t* dst  , int hi) {
#pragma unroll
    for (int db = 0; db < 2; ++db)
#pragma unroll
        for (int g4 = 0; g4 < 4; ++g4) { u32x2 w; w.x = pk2(o[db][4 * g4], o[db][4 * g4 + 1]); w.y = pk2(o[db][4 * g4 + 2], o[db][4 * g4 + 3]);
            *(u32x2*)(dst + 32 * db + 8 * g4 + 4 * hi) = w; }
}
DI void load_q(const bf16_t* zq, const float* cs, int hi, bf16x8 (&qf)[4]) {
#pragma unroll
    for (int ds = 0; ds < 2; ++ds) { const int d1 = 16 * ds + 8 * hi; float x1[8], x2[8], y1[8], y2[8];
        unpack8(*(const u32x4*)(zq + d1), x1); unpack8(*(const u32x4*)(zq + d1 + 32), x2);
#pragma unroll
        for (int e = 0; e < 8; ++e) { const float c = cs[2 * (d1 + e)], s = cs[2 * (d1 + e) + 1]; y1[e] = (x1[e] * c - x2[e] * s) * 0.125f; y2[e] = (x2[e] * c + x1[e] * s) * 0.125f; }
        qf[ds] = __builtin_bit_cast(bf16x8, pack8(y1)); qf[ds + 2] = __builtin_bit_cast(bf16x8, pack8(y2)); }
}

DI void attn_prompt_unit(const Args& A, int l, int u, unsigned char* lds, int tid, int lane, int wave) {
    unsigned char* ws = A.ws;
    const bf16_t* Z = (const bf16_t*)(ws + WS_BIG); bf16_t* CAT = (bf16_t*)(ws + WS_H); const float* rope = (const float*)(ws + WS_ROPE);
    const int b = u >> 6, kvh = (u >> 5) & 1, qb = u & 31, q0 = qb * 64;
    bf16_t* Kl = (bf16_t*)lds; bf16_t* VTl = (bf16_t*)(lds + 27648); constexpr int VST = 200;
    float* nk = A.out + O_KP + ((size_t)(l * NB + b) * 128) * 128 + kvh * 64; float* nv = A.out + O_VP + ((size_t)(l * NB + b) * 128) * 128 + kvh * 64;
    for (int it = tid; it < 192 * 4; it += NTHREADS) { const int key = it >> 2, o = it & 3; const int pos = q0 - 128 + key;
        float y1[8], y2[8];
        if (pos >= 0) { const bf16_t* zk = Z + (size_t)(b * SEQ + pos) * DIN + KA + kvh * 64 + 8 * o; float x1[8], x2[8];
            unpack8(*(const u32x4*)zk, x1); unpack8(*(const u32x4*)(zk + 32), x2); const float* cs = rope + (size_t)pos * 64 + 16 * o;
#pragma unroll
            for (int e = 0; e < 8; ++e) { const float c = cs[2 * e], s = cs[2 * e + 1]; y1[e] = x1[e] * c - x2[e] * s; y2[e] = x2[e] * c + x1[e] * s; }
            if (qb == 31 && key >= 64) { float* d = nk + (size_t)(key - 64) * 128 + 8 * o;
                *(f32x4*)d = (f32x4){y1[0], y1[1], y1[2], y1[3]}; *(f32x4*)(d + 4) = (f32x4){y1[4], y1[5], y1[6], y1[7]};
                *(f32x4*)(d + 32) = (f32x4){y2[0], y2[1], y2[2], y2[3]}; *(f32x4*)(d + 36) = (f32x4){y2[4], y2[5], y2[6], y2[7]}; }
        } else {
#pragma unroll
            for (int e = 0; e < 8; ++e) { y1[e] = 0.f; y2[e] = 0.f; } }
        *(u32x4*)(Kl + key * 72 + 8 * o) = pack8(y1); *(u32x4*)(Kl + key * 72 + 32 + 8 * o) = pack8(y2); }
    for (int it = tid; it < 192 * 8; it += NTHREADS) { const int key = it >> 3, o = it & 7; const int pos = q0 - 128 + key;
        u32x4 w = (u32x4){0u, 0u, 0u, 0u};
        if (pos >= 0) { w = *(const u32x4*)(Z + (size_t)(b * SEQ + pos) * DIN + VA + kvh * 64 + 8 * o);
            if (qb == 31 && key >= 64) { float x[8]; unpack8(w, x); float* d = nv + (size_t)(key - 64) * 128 + 8 * o;
                *(f32x4*)d = (f32x4){x[0], x[1], x[2], x[3]}; *(f32x4*)(d + 4) = (f32x4){x[4], x[5], x[6], x[7]}; } }
        bf16_t* vt = VTl + (8 * o) * VST + key;
        vt[0] = (bf16_t)(w.x & 0xffffu); vt[VST] = (bf16_t)(w.x >> 16); vt[2 * VST] = (bf16_t)(w.y & 0xffffu); vt[3 * VST] = (bf16_t)(w.y >> 16);
        vt[4 * VST] = (bf16_t)(w.z & 0xffffu); vt[5 * VST] = (bf16_t)(w.z >> 16); vt[6 * VST] = (bf16_t)(w.w & 0xffffu); vt[7 * VST] = (bf16_t)(w.w >> 16); }
    __syncthreads();
    {
        const int g = wave >> 1, half = wave & 1, r32 = lane & 31, hi = lane >> 5, head = kvh * 4 + g;
        const int qpos = q0 + 32 * half + r32; const size_t row = (size_t)b * SEQ + qpos;
        bf16x8 qf[4]; load_q(Z + row * DIN + QA + head * 64, rope + (size_t)qpos * 64, hi, qf);
        const float sink = A.in[16][l * 8 + head];
        const int kbase = q0 - 128 + 32 * half;
        f32x16 o[2];
        attn_wave32(Kl + half * 32 * 72, VTl + half * 32, VST, qf, sink,
                    [&](int key) { const int diff = 128 + r32 - key; return diff >= 0 && diff < 128 && (kbase + key) >= 0; }, r32, hi, o);
        attn_store(o, CAT + row * DM + head * 64, hi);
    }
    __syncthreads();
}

DI void attn_sample_unit(const Args& A, int l, int b, unsigned char* lds, int tid, int lane, int wave) {
    unsigned char* ws = A.ws;
    const bf16_t* Z = (const bf16_t*)(ws + WS_BIG); bf16_t* CAT = (bf16_t*)(ws + WS_H); const float* rope = (const float*)(ws + WS_ROPE);
    constexpr int VST = 168, KV_BYTES = 23040 + 21504;
    const float* ck = A.in[2] + ((size_t)(l * DB + b) * 128) * 128; const float* cv = A.in[3] + ((size_t)(l * DB + b) * 128) * 128;
    float* nk = A.out + O_KS + ((size_t)(l * DB + b) * 128) * 128; float* nv = A.out + O_VS + ((size_t)(l * DB + b) * 128) * 128;
    for (int it = tid; it < 2 * 160 * 4; it += NTHREADS) { const int kvh = it / 640, rr = it % 640, key = rr >> 2, o = rr & 3;
        bf16_t* Kl = (bf16_t*)(lds + kvh * KV_BYTES);
        float y1[8], y2[8];
        if (key < 128) { const float* s = ck + (size_t)key * 128 + kvh * 64 + 8 * o;
#pragma unroll
            for (int e = 0; e < 8; ++e) { y1[e] = s[e]; y2[e] = s[32 + e]; }
        } else if (key < 136) { const int i = key - 128; const bf16_t* zk = Z + (size_t)(MP + b * DS + i) * DIN + KA + kvh * 64 + 8 * o; float x1[8], x2[8];
            unpack8(*(const u32x4*)zk, x1); unpack8(*(const u32x4*)(zk + 32), x2); const float* cs = rope + (size_t)(2048 + i) * 64 + 16 * o;
#pragma unroll
            for (int e = 0; e < 8; ++e) { const float c = cs[2 * e], s = cs[2 * e + 1]; y1[e] = x1[e] * c - x2[e] * s; y2[e] = x2[e] * c + x1[e] * s; }
        } else {
#pragma unroll
            for (int e = 0; e < 8; ++e) { y1[e] = 0.f; y2[e] = 0.f; } }
        if (key >= 8 && key < 136) { float* d = nk + (size_t)(key - 8) * 128 + kvh * 64 + 8 * o;
#pragma unroll
            for (int e = 0; e < 8; ++e) { d[e] = y1[e]; d[32 + e] = y2[e]; } }
        *(u32x4*)(Kl + key * 72 + 8 * o) = pack8(y1); *(u32x4*)(Kl + key * 72 + 32 + 8 * o) = pack8(y2); }
    for (int it = tid; it < 2 * 160 * 8; it += NTHREADS) { const int kvh = it / 1280, rr = it % 1280, key = rr >> 3, o = rr & 7;
        bf16_t* VTl = (bf16_t*)(lds + kvh * KV_BYTES + 23040);
        float x[8];
        if (key < 128) { const float* s = cv + (size_t)key * 128 + kvh * 64 + 8 * o;
#pragma unroll
            for (int e = 0; e < 8; ++e) x[e] = s[e];
        } else if (key < 136) { unpack8(*(const u32x4*)(Z + (size_t)(MP + b * DS + key - 128) * DIN + VA + kvh * 64 + 8 * o), x);
        } else {
#pragma unroll
            for (int e = 0; e < 8; ++e) x[e] = 0.f; }
        if (key >= 8 && key < 136) { float* d = nv + (size_t)(key - 8) * 128 + kvh * 64 + 8 * o;
#pragma unroll
            for (int e = 0; e < 8; ++e) d[e] = x[e]; }
#pragma unroll
        for (int e = 0; e < 8; ++e) VTl[(8 * o + e) * VST + key] = (bf16_t)f2bf(x[e]); }
    __syncthreads();
    if (wave < 2) {
        const int kvh = wave, r32 = lane & 31, hi = lane >> 5, g = r32 >> 3, i = r32 & 7, head = kvh * 4 + g;
        const size_t row = (size_t)MP + b * DS + i;
        bf16x8 qf[4]; load_q(Z + row * DIN + QA + head * 64, rope + (size_t)(2048 + i) * 64, hi, qf);
        const float sink = A.in[16][l * 8 + head];
        f32x16 o[2];
        attn_wave32((const bf16_t*)(lds + kvh * KV_BYTES), (const bf16_t*)(lds + kvh * KV_BYTES + 23040), VST, qf, sink,
                    [&](int key) { return key < 128 ? (key > i) : (key < 136 && (key - 128) <= i); }, r32, hi, o);
        attn_store(o, CAT + row * DM + head * 64, hi);
    }
    __syncthreads();
}

DI float lb_val(const float* lbraw, int l, int idx) { if (l == 0) return 0.f; const float a = lbraw[idx], b = lbraw[256 + idx]; return 1.0f / (1.0f + __expf(a - b)); }

DI void hg_gates_cumsum(const bf16_t* Z, size_t row0, int h, const float* lbraw, int l, float* lf, float* kk, float* tot, int tid) {
    { const int t = tid >> 3, k0 = (tid & 7) * 8; float x[8];
      unpack8(*(const u32x4*)(Z + (row0 + t) * DIN + FH + h * 64 + k0), x);
#pragma unroll
      for (int e = 0; e < 8; ++e) { const float lbv = lb_val(lbraw, l, h * 64 + k0 + e); const float xv = fminf(fmaxf(x[e], -60.f), 60.f);
          const float f = lbv + (1.0f - lbv) * sigmoidf_(xv); lf[t * 64 + k0 + e] = __logf(f); kk[t * 64 + k0 + e] = (1.0f - lbv) * sigmoidf_(-xv); } }
    __syncthreads();
    { const int k = tid & 63, seg = tid >> 6; float run = 0.f;
#pragma unroll
      for (int i = 0; i < 8; ++i) { run += lf[(8 * seg + i) * 64 + k]; lf[(8 * seg + i) * 64 + k] = run; }
      tot[seg * 64 + k] = run;
      __syncthreads();
      float off = 0.f;
      for (int s = 0; s < seg; ++s) off += tot[s * 64 + k];
#pragma unroll
      for (int i = 0; i < 8; ++i) lf[(8 * seg + i) * 64 + k] += off; }
    __syncthreads();
}

DI void hg_pass1_unit(const Args& A, int l, int u, unsigned char* lds, int tid, int lane, int wave) {
    unsigned char* ws = A.ws; const bf16_t* Z = (const bf16_t*)(ws + WS_BIG);
    const int b = u >> 7, h = (u >> 5) & 3, c = u & 31; const size_t row0 = (size_t)b * SEQ + c * 64;
    float* lf = (float*)lds; float* kk = (float*)(lds + 16384); float* tot = (float*)(lds + 32768); bf16_t* KT = (bf16_t*)(lds + 36864); bf16_t* VT = (bf16_t*)(lds + 36864 + 9216);
    hg_gates_cumsum(Z, row0, h, A.in[17], l, lf, kk, tot, tid);
    { const int t = tid >> 3, k0 = (tid & 7) * 8;
#pragma unroll
      for (int e = 0; e < 8; ++e) { const int k = k0 + e; KT[k * 72 + t] = (bf16_t)f2bf(kk[t * 64 + k] * __expf(lf[63 * 64 + k] - lf[t * 64 + k])); }
      const u32x4 w = *(const u32x4*)(Z + (row0 + t) * DIN + IH + h * 64 + k0); bf16_t* vt = VT + k0 * 72 + t;
      vt[0] = (bf16_t)(w.x & 0xffffu); vt[72] = (bf16_t)(w.x >> 16); vt[144] = (bf16_t)(w.y & 0xffffu); vt[216] = (bf16_t)(w.y >> 16);
      vt[288] = (bf16_t)(w.z & 0xffffu); vt[360] = (bf16_t)(w.z >> 16); vt[432] = (bf16_t)(w.w & 0xffffu); vt[504] = (bf16_t)(w.w >> 16); }
    if (tid < 64) ((float*)(ws + WS_HD))[(size_t)u * 64 + tid] = __expf(lf[63 * 64 + tid]);
    __syncthreads();
    { const int kt = wave >> 1, q4 = lane >> 4, c16 = lane & 15; float* U = (float*)(ws + WS_HU) + (size_t)u * 4096;
#pragma unroll
      for (int vv = 0; vv < 2; ++vv) { const int vt = 2 * (wave & 1) + vv; f32x4 acc = (f32x4){0.f, 0.f, 0.f, 0.f};
#pragma unroll
          for (int ks = 0; ks < 2; ++ks) { const bf16x8 a = *(const bf16x8*)(KT + (16 * kt + c16) * 72 + 32 * ks + 8 * q4); const bf16x8 bb = *(const bf16x8*)(VT + (16 * vt + c16) * 72 + 32 * ks + 8 * q4);
              acc = MFMA16(a, bb, acc); }
#pragma unroll
          for (int e = 0; e < 4; ++e) U[(16 * kt + 4 * q4 + e) * 64 + 16 * vt + c16] = acc[e]; } }
    __syncthreads();
}

DI void hg_scan_unit(const Args& A, int l, int u, int tid) {
    unsigned char* ws = A.ws; const int b = u >> 2, h = u & 3;
    float* U = (float*)(ws + WS_HU) + ((size_t)(b * 4 + h) * 32) * 4096; const float* D = (const float*)(ws + WS_HD) + ((size_t)(b * 4 + h) * 32) * 64;
    const int k = tid >> 3, v0 = (tid & 7) * 8;
    f32x4 s0 = (f32x4){0.f, 0.f, 0.f, 0.f}, s1 = s0;
    for (int c0 = 0; c0 < 32; c0 += 8) {
        f32x4 u0[8], u1[8]; float d[8];
#pragma unroll
        for (int j = 0; j < 8; ++j) { const float* p = U + (size_t)(c0 + j) * 4096 + k * 64 + v0; u0[j] = *(const f32x4*)p; u1[j] = *(const f32x4*)(p + 4); d[j] = D[(c0 + j) * 64 + k]; }
#pragma unroll
        for (int j = 0; j < 8; ++j) { float* p = U + (size_t)(c0 + j) * 4096 + k * 64 + v0; *(f32x4*)p = s0; *(f32x4*)(p + 4) = s1; s0 = s0 * d[j] + u0[j]; s1 = s1 * d[j] + u1[j]; }
    }
    float* so = A.out + O_SP + ((size_t)((l * NB + b) * 4 + h)) * 4096 + k * 64 + v0;
    *(f32x4*)so = s0; *(f32x4*)(so + 4) = s1;
}

DI void hg_pass3_unit(const Args& A, int l, int u, unsigned char* lds, int tid, int lane, int wave) {
    unsigned char* ws = A.ws; const bf16_t* Z = (const bf16_t*)(ws + WS_BIG); bf16_t* CAT = (bf16_t*)(ws + WS_H);
    const int b = u >> 7, h = (u >> 5) & 3, c = u & 31; const size_t row0 = (size_t)b * SEQ + c * 64;
    float* bb = (float*)lds; float* kk = (float*)(lds + 16384); float* qq = (float*)(lds + 32768); float* tot = (float*)(lds + 49152);
    bf16_t* VT = (bf16_t*)(lds + 53248); bf16_t* ST = (bf16_t*)(lds + 53248 + 9216); float* ssum = (float*)(lds + 53248 + 18432);
    { const int t = tid >> 3, k0 = (tid & 7) * 8; float x[8];
      unpack8(*(const u32x4*)(Z + (row0 + t) * DIN + QH + h * 64 + k0), x);
#pragma unroll
      for (int e = 0; e < 8; ++e) qq[t * 64 + k0 + e] = x[e];
      const u32x4 w = *(const u32x4*)(Z + (row0 + t) * DIN + IH + h * 64 + k0); bf16_t* vt = VT + k0 * 72 + t;
      vt[0] = (bf16_t)(w.x & 0xffffu); vt[72] = (bf16_t)(w.x >> 16); vt[144] = (bf16_t)(w.y & 0xffffu); vt[216] = (bf16_t)(w.y >> 16);
      vt[288] = (bf16_t)(w.z & 0xffffu); vt[360] = (bf16_t)(w.z >> 16); vt[432] = (bf16_t)(w.w & 0xffffu); vt[504] = (bf16_t)(w.w >> 16);
      const float* sp = (const float*)(ws + WS_HU) + (size_t)u * 4096 + t * 64 + k0; const f32x4 a0 = *(const f32x4*)sp, a1 = *(const f32x4*)(sp + 4);
      bf16_t* st = ST + k0 * 72 + t;
      st[0] = (bf16_t)f2bf(a0.x); st[72] = (bf16_t)f2bf(a0.y); st[144] = (bf16_t)f2bf(a0.z); st[216] = (bf16_t)f2bf(a0.w);
      st[288] = (bf16_t)f2bf(a1.x); st[360] = (bf16_t)f2bf(a1.y); st[432] = (bf16_t)f2bf(a1.z); st[504] = (bf16_t)f2bf(a1.w); }
    hg_gates_cumsum(Z, row0, h, A.in[17], l, bb, kk, tot, tid);
    const int ti = wave & 3, vh = wave >> 2, q4 = lane >> 4, c16 = lane & 15; const int t = 16 * ti + c16;
    float beta[16];
#pragma unroll
    for (int ks = 0; ks < 2; ++ks)
#pragma unroll
        for (int e = 0; e < 8; ++e) { const int k = 32 * ks + 8 * q4 + e; beta[ks * 8 + e] = ti > 0 ? bb[(16 * ti - 1) * 64 + k] : 0.f; }
    bf16x8 qi[2], qo[2];
#pragma unroll
    for (int ks = 0; ks < 2; ++ks) { float a[8], o8[8];
#pragma unroll
        for (int e = 0; e < 8; ++e) { const int k = 32 * ks + 8 * q4 + e; const float bt = bb[t * 64 + k], qv = qq[t * 64 + k]; a[e] = qv * __expf(bt - beta[ks * 8 + e]); o8[e] = qv * __expf(bt); }
        qi[ks] = __builtin_bit_cast(bf16x8, pack8(a)); qo[ks] = __builtin_bit_cast(bf16x8, pack8(o8)); }
    f32x4 pt[4];
#pragma unroll
    for (int j = 0; j < 4; ++j) { pt[j] = (f32x4){0.f, 0.f, 0.f, 0.f};
        if (j <= ti) { const int s = 16 * j + c16;
#pragma unroll
            for (int ks = 0; ks < 2; ++ks) { float a[8];
#pragma unroll
                for (int e = 0; e < 8; ++e) { const int k = 32 * ks + 8 * q4 + e; a[e] = kk[s * 64 + k] * __expf(beta[ks * 8 + e] - bb[s * 64 + k]); }
                pt[j] = MFMA16(__builtin_bit_cast(bf16x8, pack8(a)), qi[ks], pt[j]); }
            if (j == ti) {
#pragma unroll
                for (int e = 0; e < 4; ++e) if (4 * q4 + e > c16) pt[j][e] = 0.f; } } }
    f32x4 o[2]; float ss = 0.f;
#pragma unroll
    for (int vv = 0; vv < 2; ++vv) { const int vt = 2 * vh + vv; const int v = 16 * vt + c16; f32x4 acc = (f32x4){0.f, 0.f, 0.f, 0.f};
#pragma unroll
        for (int p = 0; p < 2; ++p) if (2 * p <= ti) {
            u32x4 pw; pw.x = pk2(pt[2 * p][0], pt[2 * p][1]); pw.y = pk2(pt[2 * p][2], pt[2 * p][3]); pw.z = pk2(pt[2 * p + 1][0], pt[2 * p + 1][1]); pw.w = pk2(pt[2 * p + 1][2], pt[2 * p + 1][3]);
            const s16x4 lo = *(const s16x4*)(VT + v * 72 + 32 * p + 4 * q4), hi4 = *(const s16x4*)(VT + v * 72 + 32 * p + 16 + 4 * q4);
            acc = MFMA16(__builtin_shufflevector(lo, hi4, 0, 1, 2, 3, 4, 5, 6, 7), __builtin_bit_cast(bf16x8, pw), acc); }
#pragma unroll
        for (int ks = 0; ks < 2; ++ks) { const bf16x8 a = *(const bf16x8*)(ST + v * 72 + 32 * ks + 8 * q4); acc = MFMA16(a, qo[ks], acc); }
        o[vv] = acc; ss += (acc[0] * acc[0] + acc[1] * acc[1]) + (acc[2] * acc[2] + acc[3] * acc[3]); }
    ss += __shfl_xor(ss, 16); ss += __shfl_xor(ss, 32);
    if (q4 == 0) ssum[vh * 64 + t] = ss;
    __syncthreads();
    { const float rstd = rsqrtf((ssum[t] + ssum[64 + t]) * (1.0f / 64.0f) + EPS); const float* gn = A.in[18] + l * 64;
#pragma unroll
      for (int vv = 0; vv < 2; ++vv) { const int v0 = 16 * (2 * vh + vv) + 4 * q4; const u32x2 gw = *(const u32x2*)(Z + (row0 + t) * DIN + GH + h * 64 + v0);
          const float g0 = bflo(gw.x), g1 = bfhi(gw.x), g2 = bflo(gw.y), g3 = bfhi(gw.y);
          const float r0 = o[vv][0] * rstd * gn[v0] * (g0 * sigmoidf_(g0)), r1 = o[vv][1] * rstd * gn[v0 + 1] * (g1 * sigmoidf_(g1));
          const float r2 = o[vv][2] * rstd * gn[v0 + 2] * (g2 * sigmoidf_(g2)), r3 = o[vv][3] * rstd * gn[v0 + 3] * (g3 * sigmoidf_(g3));
          u32x2 w; w.x = pk2(r0, r1); w.y = pk2(r2, r3); *(u32x2*)(CAT + (row0 + t) * DM + 512 + h * 64 + v0) = w; } }
    __syncthreads();
}

DI void hg_sample_unit(const Args& A, int l, int u, unsigned char* lds, int tid, int lane, int wave) {
    unsigned char* ws = A.ws; const bf16_t* Z = (const bf16_t*)(ws + WS_BIG); bf16_t* CAT = (bf16_t*)(ws + WS_H);
    const int b = u >> 2, h = u & 3; const size_t row0 = (size_t)MP + b * DS;
    float* fs = (float*)lds; float* ks_ = fs + 512; float* qs = fs + 1024; float* vs = fs + 1536; float* red = fs + 2048;
    { const int t = tid >> 6, k = tid & 63; const bf16_t* zr = Z + (row0 + t) * DIN + h * 64 + k;
      const float lbv = lb_val(A.in[17], l, h * 64 + k); const float xv = fminf(fmaxf(bf2f(zr[FH]), -60.f), 60.f);
      fs[tid] = lbv + (1.0f - lbv) * sigmoidf_(xv); ks_[tid] = (1.0f - lbv) * sigmoidf_(-xv); qs[tid] = bf2f(zr[QH]); vs[tid] = bf2f(zr[IH]); }
    __syncthreads();
    const int v = tid & 63, ksl = tid >> 6;
    const float* s0 = A.in[4] + ((size_t)((l * DB + b) * 4 + h)) * 4096;
    float S[8];
#pragma unroll
    for (int j = 0; j < 8; ++j) S[j] = s0[(8 * ksl + j) * 64 + v];
#pragma unroll
    for (int t = 0; t < 8; ++t) { const float vt = vs[t * 64 + v]; float po = 0.f;
#pragma unroll
        for (int j = 0; j < 8; ++j) { const int k = 8 * ksl + j; S[j] = fs[t * 64 + k] * S[j] + ks_[t * 64 + k] * vt; po += S[j] * qs[t * 64 + k]; }
        red[(t * 8 + ksl) * 64 + v] = po; }
    float* so = A.out + O_SS + ((size_t)((l * DB + b) * 4 + h)) * 4096;
#pragma unroll
    for (int j = 0; j < 8; ++j) so[(8 * ksl + j) * 64 + v] = S[j];
    __syncthreads();
    { const int t = tid >> 6; float o = 0.f;
#pragma unroll
      for (int s = 0; s < 8; ++s) o += red[(t * 8 + s) * 64 + v];
      const float rstd = rsqrtf(wave_sum(o * o) * (1.0f / 64.0f) + EPS);
      const float g = bf2f(Z[(row0 + t) * DIN + GH + h * 64 + v]);
      CAT[(row0 + t) * DM + 512 + h * 64 + v] = (bf16_t)f2bf(o * rstd * A.in[18][l * 64 + v] * (g * sigmoidf_(g))); }
    __syncthreads();
}

DI void conv_unit(const Args& A, int l, int u, int tid) {
    unsigned char* ws = A.ws; const bf16_t* Z = (const bf16_t*)(ws + WS_BIG); bf16_t* CAT = (bf16_t*)(ws + WS_H);
    const int r = u * 16 + (tid >> 5), c0 = (tid & 31) * 8;
    int t, T, b; bool samp = r >= MP;
    if (!samp) { b = r >> 11; t = r & 2047; T = SEQ; } else { b = (r - MP) >> 3; t = (r - MP) & 7; T = DS; }
    float u0[8], u1[8], u2[8], bc[8], x[8], y[8];
    { const bf16_t* z = Z + (size_t)r * DIN; unpack8(*(const u32x4*)(z + CC + c0), x); unpack8(*(const u32x4*)(z + HC + c0), y); unpack8(*(const u32x4*)(z + BC + c0), bc);
#pragma unroll
      for (int e = 0; e < 8; ++e) u2[e] = x[e] * y[e]; }
    if (t >= 1) { const bf16_t* z = Z + (size_t)(r - 1) * DIN; unpack8(*(const u32x4*)(z + CC + c0), x); unpack8(*(const u32x4*)(z + HC + c0), y);
#pragma unroll
        for (int e = 0; e < 8; ++e) u1[e] = x[e] * y[e];
    } else {
#pragma unroll
        for (int e = 0; e < 8; ++e) u1[e] = samp ? A.in[5][((size_t)(l * DB + b) * 2 + 1) * 256 + c0 + e] : 0.f; }
    if (t >= 2) { const bf16_t* z = Z + (size_t)(r - 2) * DIN; unpack8(*(const u32x4*)(z + CC + c0), x); unpack8(*(const u32x4*)(z + HC + c0), y);
#pragma unroll
        for (int e = 0; e < 8; ++e) u0[e] = x[e] * y[e];
    } else {
#pragma unroll
        for (int e = 0; e < 8; ++e) u0[e] = samp ? A.in[5][((size_t)(l * DB + b) * 2 + t) * 256 + c0 + e] : 0.f; }
    const float* cw = A.in[19] + (size_t)l * 3 * 256 + c0; float o[8];
#pragma unroll
    for (int e = 0; e < 8; ++e) o[e] = bc[e] * (u0[e] * cw[e] + u1[e] * cw[256 + e] + u2[e] * cw[512 + e]);
    *(u32x4*)(CAT + (size_t)r * DM + 768 + c0) = pack8(o);
    if (t >= T - 2) { float* d = samp ? A.out + O_CS + ((size_t)(l * DB + b) * 2 + (t - (T - 2))) * 256 + c0 : A.out + O_CP + ((size_t)(l * NB + b) * 2 + (t - (T - 2))) * 256 + c0;
#pragma unroll
        for (int e = 0; e < 8; ++e) d[e] = u2[e]; }
}

#define XB_TMO      128
#define XB_XCNT(j)  (256  + 64 * (j))
#define XB_XSUB(j)  (1280 + 64 * (j))
#define XB_XGEN(j)  (2304 + 64 * (j))
#define XB_TOP      3328
#define XB_TOPGEN   3392
#define XCD_BAR_WORDS 3456
#define XB_SPIN_CAP (1u << 18)

__device__ __forceinline__ unsigned xb_ld(unsigned* p)              { return __hip_atomic_load(p, __ATOMIC_RELAXED, __HIP_MEMORY_SCOPE_AGENT); }
__device__ __forceinline__ unsigned xb_add(unsigned* p, unsigned v) { return __hip_atomic_fetch_add(p, v, __ATOMIC_RELAXED, __HIP_MEMORY_SCOPE_AGENT); }
__device__ __forceinline__ unsigned xb_xcc_id() { return (unsigned)__builtin_amdgcn_s_getreg((3 << 11) | 20) & 0xFu; }
#define XB_SPIN(cond, bar) do { unsigned _sp = 0; while (cond) { __builtin_amdgcn_s_sleep(1); \
    if ((++_sp & 255u) == 0u) { if (xb_ld(&(bar)[XB_TMO])) break; if (_sp > XB_SPIN_CAP) { atomicAdd(&(bar)[XB_TMO], 1u); break; } } } } while (0)

struct XcdBarrier {
    unsigned* bar; unsigned x;
    volatile LAS unsigned* st;
};

__device__ __forceinline__ XcdBarrier xcd_barrier_post(unsigned* bar, volatile LAS unsigned* st) {
    XcdBarrier b; b.bar = bar; b.x = xb_xcc_id(); b.st = st;
    if (threadIdx.x == 0) (void)xb_add(&bar[XB_XCNT(b.x)], 1u);
    return b;
}
__device__ __forceinline__ void xcd_barrier_complete(unsigned* bar, unsigned x, unsigned& nloc, unsigned& nx) {
    const unsigned G = gridDim.x * gridDim.y * gridDim.z;
    unsigned sum, cnt, mine, sp = 0u;
    for (;;) {
        sum = 0u; cnt = 0u; mine = 0u;
#pragma unroll
        for (unsigned j = 0; j < 16; ++j) { const unsigned c = xb_ld(&bar[XB_XCNT(j)]); sum += c; cnt += (c > 0u) ? 1u : 0u; mine = (j == x) ? c : mine; }
        if (sum == G) break;
        __builtin_amdgcn_s_sleep(1);
        if ((++sp & 255u) == 0u) { if (xb_ld(&bar[XB_TMO])) break; if (sp > XB_SPIN_CAP) { atomicAdd(&bar[XB_TMO], 1u); break; } }
    }
    nloc = mine > 0u ? mine : 1u; nx = cnt > 0u ? cnt : 1u;
}

__device__ __forceinline__ void xcd_barrier(const XcdBarrier& b) {
    asm volatile("s_waitcnt vmcnt(0)" ::: "memory");
    __syncthreads();
    if (threadIdx.x == 0) {
        unsigned* bar = b.bar;
        __builtin_amdgcn_s_waitcnt(0);
        unsigned nloc = b.st[0], nx = b.st[1];
        if (nloc == 0u) { xcd_barrier_complete(bar, b.x, nloc, nx); b.st[0] = nloc; b.st[1] = nx; }
        const unsigned old = xb_add(&bar[XB_XSUB(b.x)], 1u);
        const unsigned gen = old / nloc;
        if (old + 1u == (gen + 1u) * nloc) {
            __builtin_amdgcn_fence(__ATOMIC_RELEASE, "agent");
            asm volatile("s_waitcnt vmcnt(0)" ::: "memory");
            const unsigned og = xb_add(&bar[XB_TOP], 1u);
            const unsigned tg = og / nx;
            if (og + 1u == (tg + 1u) * nx) xb_add(&bar[XB_TOPGEN], 1u);
            else XB_SPIN(xb_ld(&bar[XB_TOPGEN]) == tg, bar);
            __builtin_amdgcn_fence(__ATOMIC_ACQUIRE, "agent");
            xb_add(&bar[XB_XGEN(b.x)], 1u);
            asm volatile("s_waitcnt vmcnt(0)" ::: "memory");
        } else {
            XB_SPIN(xb_ld(&bar[XB_XGEN(b.x)]) == gen, bar);
            __builtin_amdgcn_fence(__ATOMIC_ACQUIRE, "agent");
            asm volatile("s_waitcnt vmcnt(0)" ::: "memory");
        }
    }
    __syncthreads();
}

__global__ void __launch_bounds__(NTHREADS, 2) hymba_fwd(Args A_unused) {
    extern __shared__ __attribute__((aligned(16))) unsigned char lds[];
    cg::grid_group grid = cg::this_grid();
    LAS unsigned char* ldsl = (LAS unsigned char*)lds;
#define LOADARGS() const __attribute__((address_space(4))) Args* ap_ = (const __attribute__((address_space(4))) Args*)__builtin_amdgcn_kernarg_segment_ptr(); asm volatile("" : "+s"(ap_)); Args A; _Pragma("unroll") for (int i_ = 0; i_ < 20; ++i_) A.in[i_] = ap_->in[i_]; A.out = ap_->out; A.ws = ap_->ws; unsigned char* ws = A.ws; (void)ws; int tid = threadIdx.x; asm volatile("" : "+v"(tid)); const int lane = tid & 63, wave = __builtin_amdgcn_readfirstlane(tid >> 6); (void)lane; (void)wave
    for (int u_ = threadIdx.x; u_ < (LDS_BYTES - 131072) / 4; u_ += NTHREADS) ((LAS unsigned*)(ldsl + 131072))[u_] = 0u;
    __syncthreads();
    XcdBarrier bar;
    { const __attribute__((address_space(4))) Args* ap0_ = (const __attribute__((address_space(4))) Args*)__builtin_amdgcn_kernarg_segment_ptr();
      bar = xcd_barrier_post((unsigned*)(ap0_->ws + WS_CTL), (volatile LAS unsigned*)(ldsl + 131072 + 64)); }
#define GSYNC() xcd_barrier(bar)

#ifndef SKIP_P0
#ifndef REP_P0
#define REP_P0 1
#endif
    for (int rep_ = 0; rep_ < REP_P0; ++rep_) { LOADARGS(); p0_prologue(A, lds, tid, lane, wave); }
#endif
    grid.sync();
    { LOADARGS(); pg8::Gemm g{(const pg8::bf16_t*)(ws + WS_AMOD), (const pg8::bf16_t*)(ws + WS_WADA), 256, 2 * NMOD, DM}; pg8::StaticOrder S; S.init(256, 2 * NMOD, gridDim.x, blockIdx.x);
      pg8::EpiModF32 E{(float*)(ws + WS_MOD), A.in[9], NBT, NMOD};

#ifndef SKIP_G1
      pg8::gemm_phase<pg8::EpiModF32, pg8::StaticOrder, true, true>(ldsl, g, S, E);
#endif
 }
    GSYNC();

#ifndef SKIP_R1
    { LOADARGS(); row_pass(A, false, 0, 0, 0.f, true, 0, 0, true, lane, wave); }
#endif

    GSYNC();
    for (int l = 0; l < NL; ++l) {
        for (int f = 0; f < 2; ++f) {
            if (f == 1) {
                { LOADARGS(); pg8::Gemm g{(const pg8::bf16_t*)(ws + WS_H), (const pg8::bf16_t*)(ws + WS_WMIN) + (size_t)l * DIN * DM, MT, DIN, DM}; pg8::StaticOrder S; S.init(MT, DIN, gridDim.x, blockIdx.x);
                  pg8::EpiBf16 E{(pg8::bf16_t*)(ws + WS_BIG), DIN};

#ifndef SKIP_G2
                  pg8::gemm_phase<pg8::EpiBf16, pg8::StaticOrder, true, true>(ldsl, g, S, E);
#endif
 }
                GSYNC();
#ifndef REP_MIX
#define REP_MIX 1
#endif
                for (int rep_ = 0; rep_ < REP_MIX; ++rep_) {
                for (int u = blockIdx.x; u < 2048 + 2112 + 512; u += gridDim.x) { LOADARGS();
#ifndef SKIP_HP1
                    if (u < 2048) hg_pass1_unit(A, l, u, lds, tid, lane, wave);
#endif
#ifndef SKIP_CONV
                    if (u >= 2048 && u < 2048 + 2112) conv_unit(A, l, u - 2048, tid);
#endif
#ifndef SKIP_HS
                    if (u >= 2048 + 2112) hg_sample_unit(A, l, u - 2048 - 2112, lds, tid, lane, wave);
#endif
                }
                GSYNC();
                for (int u = blockIdx.x; u < 64 + 1024 + 128; u += gridDim.x) { LOADARGS();
#ifndef SKIP_SCAN
                    if (u < 64) hg_scan_unit(A, l, u, tid);
#endif
#ifndef SKIP_AP
                    if (u >= 64 && u < 64 + 1024) attn_prompt_unit(A, l, u - 64, lds, tid, lane, wave);
#endif
#ifndef SKIP_AS
                    if (u >= 64 + 1024) attn_sample_unit(A, l, u - 64 - 1024, lds, tid, lane, wave);
#endif
                }
                GSYNC();
#ifndef SKIP_HP3
                for (int u = blockIdx.x; u < 2048; u += gridDim.x) { LOADARGS(); hg_pass3_unit(A, l, u, lds, tid, lane, wave); }
#endif
                GSYNC();
                }
                { LOADARGS(); pg8::Gemm g{(const pg8::bf16_t*)(ws + WS_H), (const pg8::bf16_t*)(ws + WS_WMOUT) + (size_t)l * DM * DM, MT, DM, DM}; pg8::StaticOrder S; S.init(MT, DM, gridDim.x, blockIdx.x);
                  pg8::EpiBf16 E{(pg8::bf16_t*)(ws + WS_OUT), DM};

#ifndef SKIP_G3
                  pg8::gemm_phase<pg8::EpiBf16, pg8::StaticOrder, true, true>(ldsl, g, S, E);
#endif
 }
                GSYNC();

#ifndef SKIP_R2
                { LOADARGS(); row_pass(A, true, l, 1, 1.0f, true, l, 2, false, lane, wave); }
#endif

                GSYNC();
            }
            { LOADARGS(); pg8::Gemm g{(const pg8::bf16_t*)(ws + WS_H), (const pg8::bf16_t*)(ws + WS_WIN) + (size_t)(l * 2 + f) * 2 * DFF * DM, MT, 2 * DFF, DM}; pg8::StaticOrder S; S.init(MT, 2 * DFF, gridDim.x, blockIdx.x);
              pg8::EpiSwiGLU E{(pg8::bf16_t*)(ws + WS_BIG), DFF};

#ifndef SKIP_G4
              pg8::gemm_phase<pg8::EpiSwiGLU, pg8::StaticOrder, true, true>(ldsl, g, S, E);
#endif
 }
            GSYNC();
            { LOADARGS(); pg8::Gemm g{(const pg8::bf16_t*)(ws + WS_BIG), (const pg8::bf16_t*)(ws + WS_WOUT) + (size_t)(l * 2 + f) * DM * DFF, MT, DM, DFF}; pg8::StaticOrder S; S.init(MT, DM, gridDim.x, blockIdx.x);
              pg8::EpiBf16 E{(pg8::bf16_t*)(ws + WS_OUT), DM};

#ifndef SKIP_G5
              pg8::gemm_phase<pg8::EpiBf16, pg8::StaticOrder, true, true>(ldsl, g, S, E);
#endif
 }
            GSYNC();

#ifndef SKIP_R3
            if (f == 0) { LOADARGS(); row_pass(A, true, l, 0, 0.5f, true, l, 1, false, lane, wave); }
#endif


#ifndef SKIP_R4
            if (f == 1) { LOADARGS(); row_pass(A, true, l, 2, 0.5f, l + 1 < NL, l + 1, 0, false, lane, wave); }
#endif

            GSYNC();
        }
    }
}

extern "C" void kernel_launch(void* const* d_in, const int* in_sizes, int n_in, void* d_out, int out_size, void* d_ws, size_t ws_size, hipStream_t stream) {
    static int grid = 0;
    if (grid == 0) {
        if (n_in != 20 || (size_t)out_size != O_END || ws_size < WS_END) { fprintf(stderr, "kernel_launch: unexpected sizes n_in %d out %d ws %zu\n", n_in, out_size, ws_size); grid = -1; return; }
        int dev = 0, cus = 0, per_cu = 0;
        hipGetDevice(&dev); hipDeviceGetAttribute(&cus, hipDeviceAttributeMultiprocessorCount, dev);
        if (hipFuncSetAttribute((const void*)hymba_fwd, hipFuncAttributeMaxDynamicSharedMemorySize, LDS_BYTES) != hipSuccess) { fprintf(stderr, "kernel_launch: hipFuncSetAttribute failed\n"); grid = -1; return; }
        if (hipOccupancyMaxActiveBlocksPerMultiprocessor(&per_cu, (const void*)hymba_fwd, NTHREADS, LDS_BYTES) != hipSuccess || per_cu < 1) { fprintf(stderr, "kernel_launch: occupancy query says %d\n", per_cu); (void)hipGetLastError(); }
        grid = cus;
    }
    if (grid < 0) return;
    if (hipMemsetAsync((char*)d_ws + WS_CTL, 0, CTL_BYTES, stream) != hipSuccess) { fprintf(stderr, "kernel_launch: memset failed\n"); return; }
    Args a{};
    for (int i = 0; i < 20; ++i) a.in[i] = (const float*)d_in[i];
    a.out = (float*)d_out; a.ws = (unsigned char*)d_ws;
    void* args[] = {&a};
    hipError_t e = hipLaunchCooperativeKernel((const void*)hymba_fwd, dim3(grid), dim3(NTHREADS), args, LDS_BYTES, stream);
    if (e != hipSuccess) fprintf(stderr, "cooperative launch failed: %s (grid %d)\n", hipGetErrorString(e), grid);
}
```
